# Optimizing an MI355X kernel written in HIP

```python
import jax, jax.numpy as jnp
from jax import lax
import numpy as np

D_MODEL = 1024
BATCH = 16
SEQ = 2048
DEPTH = 1

HEAD_DIM = 64
ATTN_GROUPS = ((128, 1), (512, 4), (2048, 16))
HEADS_PER_GROUP = 4
N_ATTN_HEADS = HEADS_PER_GROUP * len(ATTN_GROUPS)
ATTN_WIDTH = N_ATTN_HEADS * HEAD_DIM
BLK = 128
ROPE_THETA = 10000.0
SGU_CHUNK = 128
SGU_GROUPS = 12
SGU_GROUP_DIM = 64
SGU_WIDTH = SGU_GROUPS * SGU_GROUP_DIM
IN_WIDTH = 3 * ATTN_WIDTH + 2 * SGU_WIDTH + 2 * D_MODEL
SPLITS = (ATTN_WIDTH, 2 * ATTN_WIDTH, 3 * ATTN_WIDTH, 3 * ATTN_WIDTH + 2 * SGU_WIDTH, 3 * ATTN_WIDTH + 2 * SGU_WIDTH + D_MODEL)
N_EXPERTS = 32
TOP_K = 4
D_EXPERT = D_MODEL
SWIGLU_LIMIT = 7.0
SWIGLU_ALPHA = 1.702
MOE_BLOCK = 128
EPS = 1e-6
NEG_INF = -1e30

kernel_name = "hybrid_dilated_attn_sgu_moe"


def rms_norm(x, g):
    x32 = x.astype(jnp.float32)
    y = x32 * lax.rsqrt(jnp.mean(x32 * x32, axis=-1, keepdims=True) + EPS)
    return (y * g.astype(jnp.float32)).astype(x.dtype)


def layer_norm(x, g, b):
    x32 = x.astype(jnp.float32)
    mu = jnp.mean(x32, axis=-1, keepdims=True)
    xc = x32 - mu
    y = xc * lax.rsqrt(jnp.mean(xc * xc, axis=-1, keepdims=True) + EPS)
    return (y * g.astype(jnp.float32) + b.astype(jnp.float32)).astype(x.dtype)


def rope(x, positions):
    half = HEAD_DIM // 2
    inv_freq = ROPE_THETA ** (-jnp.arange(half, dtype=jnp.float32) / half)
    ang = positions.astype(jnp.float32)[..., None] * inv_freq
    cos = jnp.cos(ang)[:, :, None, :]
    sin = jnp.sin(ang)[:, :, None, :]
    x32 = x.astype(jnp.float32)
    x1, x2 = x32[..., :half], x32[..., half:]
    out = jnp.concatenate([x1 * cos - x2 * sin, x2 * cos + x1 * sin], axis=-1)
    return out.astype(x.dtype)


def dilated_window_attention(q, k, v, window, dilation):
    B, S, H, hd = q.shape
    n_back = window // dilation
    assert n_back <= BLK
    L = S // dilation
    nb = -(-L // BLK)
    Lp = nb * BLK

    def to_res(t):
        return t.reshape(B, L, dilation, H, hd).transpose(0, 2, 3, 1, 4)

    qr = jnp.pad(to_res(q), ((0, 0), (0, 0), (0, 0), (0, Lp - L), (0, 0)))
    qr = qr.reshape(B, dilation, H, nb, BLK, hd)

    def windows(t):
        tp = jnp.pad(to_res(t), ((0, 0), (0, 0), (0, 0), (BLK, Lp - L), (0, 0)))
        tp = tp.reshape(B, dilation, H, nb + 1, BLK, hd)
        return jnp.concatenate([tp[:, :, :, :-1], tp[:, :, :, 1:]], axis=4)

    kw = windows(k)
    vw = windows(v)
    s = jnp.einsum('brhnqc,brhnkc->brhnqk', qr.astype(jnp.float32), kw.astype(jnp.float32)) * (hd ** -0.5)
    qi = jnp.arange(BLK)[:, None]
    kj = jnp.arange(2 * BLK)[None, :]
    dist = BLK + qi - kj
    key_m = jnp.arange(nb)[:, None, None] * BLK + kj[None] - BLK
    valid = (dist >= 0)[None] & (dist <= n_back)[None] & (key_m >= 0)
    s = jnp.where(valid, s, NEG_INF)
    m = jnp.max(s, axis=-1, keepdims=True)
    p = jnp.exp(s - m)
    l = jnp.sum(p, axis=-1, keepdims=True)
    o = jnp.einsum('brhnqk,brhnkc->brhnqc', p, vw.astype(jnp.float32)) / l
    lse = (m + jnp.log(l))[..., 0]
    o = o.reshape(B, dilation, H, Lp, hd)[:, :, :, :L].transpose(0, 3, 1, 2, 4).reshape(B, S, H, hd)
    lse = lse.reshape(B, dilation, H, Lp)[:, :, :, :L].transpose(0, 3, 1, 2).reshape(B, S, H)
    return o, lse


def spatial_gating(z, ln_g, ln_b, w_s, b_s):
    B, S, _ = z.shape
    u, v = z[..., :SGU_WIDTH], z[..., SGU_WIDTH:]
    v = layer_norm(v, ln_g, ln_b)
    vg = v.reshape(B, S // SGU_CHUNK, SGU_CHUNK, SGU_GROUPS, SGU_GROUP_DIM)
    causal = jnp.tril(jnp.ones((SGU_CHUNK, SGU_CHUNK), dtype=bool))
    w = jnp.where(causal[None], w_s, jnp.zeros_like(w_s))
    mixed = jnp.einsum('gts,bcsgd->bctgd', w, vg) + b_s.T[None, None, :, :, None]
    return u * mixed.reshape(B, S, SGU_WIDTH)


def mixer_block(x, positions, norm1_g, w_in, q_norm_g, k_norm_g, sgu_ln_g, sgu_ln_b,
                w_spatial, b_spatial, w_branch_a, w_branch_b, w_out):
    B, S, _ = x.shape
    h = rms_norm(x, norm1_g)
    proj = h @ w_in
    q, k, v, z, g_a, g_b = jnp.split(proj, SPLITS, axis=-1)
    q = rope(rms_norm(q.reshape(B, S, N_ATTN_HEADS, HEAD_DIM), q_norm_g), positions)
    k = rope(rms_norm(k.reshape(B, S, N_ATTN_HEADS, HEAD_DIM), k_norm_g), positions)
    v = v.reshape(B, S, N_ATTN_HEADS, HEAD_DIM)
    outs, lses = [], []
    for gi, (window, dilation) in enumerate(ATTN_GROUPS):
        sl = slice(gi * HEADS_PER_GROUP, (gi + 1) * HEADS_PER_GROUP)
        o, lse = dilated_window_attention(q[:, :, sl], k[:, :, sl], v[:, :, sl], window, dilation)
        outs.append(o)
        lses.append(lse)
    alpha = jax.nn.softmax(jnp.stack(lses, axis=0), axis=0)
    attn = jnp.concatenate([outs[i] * alpha[i][..., None] for i in range(len(ATTN_GROUPS))], axis=2)
    attn = attn.reshape(B, S, ATTN_WIDTH).astype(x.dtype)
    y_a = attn @ w_branch_a
    sgu = spatial_gating(jax.nn.gelu(z, approximate=False), sgu_ln_g, sgu_ln_b, w_spatial, b_spatial)
    y_b = sgu @ w_branch_b
    merged = jax.nn.sigmoid(g_a) * y_a + jax.nn.sigmoid(g_b) * y_b
    return x + merged @ w_out


def moe_block(x, norm2_g, w_router, b_router, w_gate_up, b_gate_up, w_down, b_down):
    B, S, D = x.shape
    T = B * S
    hf = rms_norm(x, norm2_g).reshape(T, D)
    logits = (hf @ w_router + b_router).astype(jnp.float32)
    top_v, top_e = lax.top_k(logits, TOP_K)
    gates = jax.nn.softmax(top_v, axis=-1)
    n_assign = T * TOP_K
    e_flat = top_e.reshape(-1)
    w_flat = gates.reshape(-1)
    tok_flat = jnp.arange(n_assign, dtype=jnp.int32) // TOP_K
    order = jnp.argsort(e_flat)
    e_sorted = e_flat[order]
    counts = jnp.bincount(e_flat, length=N_EXPERTS)
    padded = (counts + MOE_BLOCK - 1) // MOE_BLOCK * MOE_BLOCK
    start = jnp.cumsum(counts) - counts
    pend = jnp.cumsum(padded)
    pstart = pend - padded
    dest = pstart[e_sorted] + (jnp.arange(n_assign) - start[e_sorted])
    cap = (-(-n_assign // MOE_BLOCK) + N_EXPERTS) * MOE_BLOCK
    n_blocks = cap // MOE_BLOCK
    buf_tok = jnp.full((cap,), T, dtype=jnp.int32).at[dest].set(tok_flat[order])
    buf_w = jnp.zeros((cap,), jnp.float32).at[dest].set(w_flat[order])
    blk_e = jnp.sum(jnp.arange(n_blocks)[:, None] * MOE_BLOCK >= pend[None, :], axis=1)
    blk_e = jnp.minimum(blk_e, N_EXPERTS - 1)
    hpad = jnp.concatenate([hf, jnp.zeros((1, D), hf.dtype)], axis=0)
    xb = hpad[buf_tok].reshape(n_blocks, MOE_BLOCK, D)

    def expert_rows(args):
        xblk, e = args
        gu = xblk @ w_gate_up[e] + b_gate_up[e]
        gate, up = gu[:, :D_EXPERT], gu[:, D_EXPERT:]
        gate = jnp.minimum(gate, SWIGLU_LIMIT)
        up = jnp.clip(up, -SWIGLU_LIMIT, SWIGLU_LIMIT)
        act = (up + 1.0) * (gate * jax.nn.sigmoid(SWIGLU_ALPHA * gate))
        return act @ w_down[e] + b_down[e]

    yb = lax.map(expert_rows, (xb, blk_e)).reshape(cap, D)
    y = jnp.zeros((T + 1, D), jnp.float32).at[buf_tok].add(yb.astype(jnp.float32) * buf_w[:, None])[:T]
    return x + y.reshape(B, S, D).astype(x.dtype)


def setup_inputs(seed: int = 0) -> dict:
    key = jax.random.key(seed)
    ks = jax.random.split(key, 20)
    f32 = jnp.float32
    nrm = lambda k, shape, scale: jax.random.normal(k, shape, f32) * scale
    x = jax.random.normal(ks[0], (BATCH, SEQ, D_MODEL), f32)
    offset = jax.random.randint(ks[1], (BATCH, 1), 0, 1024, dtype=jnp.int32)
    positions = offset + jnp.arange(SEQ, dtype=jnp.int32)[None, :]
    return {
        "x": x,
        "positions": positions,
        "norm1_g": 1.0 + nrm(ks[2], (DEPTH, D_MODEL), 0.02),
        "w_in": nrm(ks[3], (DEPTH, D_MODEL, IN_WIDTH), D_MODEL ** -0.5),
        "q_norm_g": 1.0 + nrm(ks[4], (DEPTH, HEAD_DIM), 0.02),
        "k_norm_g": 1.0 + nrm(ks[5], (DEPTH, HEAD_DIM), 0.02),
        "sgu_ln_g": 1.0 + nrm(ks[6], (DEPTH, SGU_WIDTH), 0.02),
        "sgu_ln_b": nrm(ks[7], (DEPTH, SGU_WIDTH), 0.02),
        "w_spatial": nrm(ks[8], (DEPTH, SGU_GROUPS, SGU_CHUNK, SGU_CHUNK), SGU_CHUNK ** -0.5),
        "b_spatial": 1.0 + nrm(ks[9], (DEPTH, SGU_GROUPS, SGU_CHUNK), 0.1),
        "w_branch_a": nrm(ks[10], (DEPTH, ATTN_WIDTH, D_MODEL), ATTN_WIDTH ** -0.5),
        "w_branch_b": nrm(ks[11], (DEPTH, SGU_WIDTH, D_MODEL), SGU_WIDTH ** -0.5),
        "w_out": nrm(ks[12], (DEPTH, D_MODEL, D_MODEL), D_MODEL ** -0.5),
        "norm2_g": 1.0 + nrm(ks[13], (DEPTH, D_MODEL), 0.02),
        "w_router": nrm(ks[14], (DEPTH, D_MODEL, N_EXPERTS), D_MODEL ** -0.5),
        "b_router": nrm(ks[15], (DEPTH, N_EXPERTS), 0.01),
        "w_gate_up": nrm(ks[16], (DEPTH, N_EXPERTS, D_MODEL, 2 * D_EXPERT), D_MODEL ** -0.5),
        "b_gate_up": nrm(ks[17], (DEPTH, N_EXPERTS, 2 * D_EXPERT), 0.01),
        "w_down": nrm(ks[18], (DEPTH, N_EXPERTS, D_EXPERT, D_MODEL), D_EXPERT ** -0.5),
        "b_down": nrm(ks[19], (DEPTH, N_EXPERTS, D_MODEL), 0.01),
    }


def reference(x, positions, norm1_g, w_in, q_norm_g, k_norm_g, sgu_ln_g, sgu_ln_b,
              w_spatial, b_spatial, w_branch_a, w_branch_b, w_out, norm2_g,
              w_router, b_router, w_gate_up, b_gate_up, w_down, b_down):
    for layer in range(DEPTH):
        x = mixer_block(x, positions, norm1_g[layer], w_in[layer], q_norm_g[layer], k_norm_g[layer],
                        sgu_ln_g[layer], sgu_ln_b[layer], w_spatial[layer], b_spatial[layer],
                        w_branch_a[layer], w_branch_b[layer], w_out[layer])
        x = moe_block(x, norm2_g[layer], w_router[layer], b_router[layer], w_gate_up[layer],
                      b_gate_up[layer], w_down[layer], b_down[layer])
    return x
```

```cpp
#include <hip/hip_runtime.h>
#include <cstdio>
#include <cstdint>
namespace pg8 {
#define PG8_LAS __attribute__((address_space(3)))
typedef unsigned short bf16_t;
typedef short bf16x8 __attribute__((ext_vector_type(8)));
typedef float f32x4 __attribute__((ext_vector_type(4)));
typedef unsigned u32x4 __attribute__((ext_vector_type(4)));
constexpr int BM = 256, BK = 64, HALF = 128, HTB = HALF * BK * 2  , STAGE_BYTES = 8 * HTB, NXCD = 8, WGM = 8;

__host__ __device__ __forceinline__ int lds_byte(int r, int c) { const int st = (r >> 4) * 2 + (c >> 5), rr = r & 15, cc = c & 31, ob = rr * 64 + cc * 2; return st * 1024 + (ob ^ (((ob >> 9) & 1) << 5)); }
__host__ __device__ __forceinline__ void stage_rc(int b, int& R, int& C) { const int st = b / 1024, sb = b % 1024, swz = sb ^ (((sb >> 9) & 1) << 5); R = (st >> 1) * 16 + swz / 64; C = (st & 1) * 32 + (swz % 64) / 2; }
__host__ __device__ __forceinline__ int perm32(int rho) { const int n = rho >> 4, i = rho & 15; return 8 * (i >> 2) + 4 * n + (i & 3); }

struct Unit { int pm, pn, gl, gn, e, ob; };
struct Gemm { const bf16_t* A; const bf16_t* Bt; int M, N, K; };

struct StaticOrder {
    int nM, nN, nwg, G, c;
    __host__ __device__ void init(int M, int N, int G_, int c_) { nM = M / BM; nN = N / BM; nwg = nM * nN; G = G_; c = c_; }
    __host__ __device__ bool next(int i, Unit& u) const {
        const long L = (long)i * G + c; if (L >= nwg) return false;
        int wgid = (int)L; { const int q = nwg / NXCD, r = nwg % NXCD, xcd = wgid % NXCD, off = wgid / NXCD; wgid = (xcd < r ? xcd * (q + 1) : r * (q + 1) + (xcd - r) * q) + off; }
        const int nig = WGM * nN, gid = wgid / nig, fm = gid * WGM, gsz = (nM - fm) < WGM ? (nM - fm) : WGM;
        u.pm = fm + ((wgid % nig) % gsz); u.pn = (wgid % nig) / gsz; u.gl = 0; u.gn = 0; u.e = 0; u.ob = 0; return true;
    }
    __device__ __forceinline__ void a_ready(const Unit&) const {}
    __device__ __forceinline__ void done(const Unit&) const {}
};

__device__ __forceinline__ unsigned cvt_pk_bf16(float lo, float hi) { unsigned r; asm volatile("v_cvt_pk_bf16_f32 %0, %1, %2" : "=v"(r) : "v"(lo), "v"(hi)); return r; }
typedef float f32x2 __attribute__((ext_vector_type(2)));
__device__ __forceinline__ f32x2 gelu_pk(f32x2 v) {
    const f32x2 av = __builtin_elementwise_abs(v), d = av * 0.2316418882f + 1.0f;
    f32x2 t; t.x = __builtin_amdgcn_rcpf(d.x); t.y = __builtin_amdgcn_rcpf(d.y);
    f32x2 q = t * 0.5307027145f + (-0.7265760135f); q = q * t + 0.7107068705f; q = q * t + (-0.142248368f); q = q * t + 0.127414796f; q = q * t;
    const f32x2 s = (v * v) * (-0.72134752044f);
    f32x2 e; e.x = __builtin_amdgcn_exp2f(s.x); e.y = __builtin_amdgcn_exp2f(s.y);
    const f32x2 m = v * (q * e), r = v - m;
    f32x2 o; o.x = v.x < 0.f ? m.x : r.x; o.y = v.y < 0.f ? m.y : r.y; return o;
}

template <int ACT  > struct EpiBf16 {
    static constexpr bool PERM = true, AFTER_DRAIN = false; static_assert(ACT == 0 || ACT == 1, "EpiBf16: ACT is 0 (none) or 1 (gelu_pk)");
    bf16_t* O; int ldc; const float* bias; int split_cols; size_t split_stride; float scale0;
    __device__ __forceinline__ void operator()(const f32x4 (&acc)[2][2][4][2], const Unit& u, int wr, int wc, int fr, int fq) const {
        const int row0 = u.pm * BM + wr * 64 + fr; int colt = u.pn * BM; bf16_t* base = O;
        float sc = 1.f; if (split_cols) { const int t = colt / split_cols; base += (size_t)t * split_stride; colt -= t * split_cols; if (t == 0) sc = scale0; }
        const int col0 = colt + wc * 32 + 8 * fq, bcol0 = u.pn * BM + wc * 32 + 8 * fq;
        f32x4 bv[2][2];
#pragma unroll
        for (int bj = 0; bj < 2; ++bj)
#pragma unroll
            for (int n = 0; n < 2; ++n) bv[bj][n] = bias ? *(const f32x4*)(bias + bcol0 + bj * HALF + 4 * n) : (f32x4){0.f, 0.f, 0.f, 0.f};
#pragma unroll
        for (int ai = 0; ai < 2; ++ai)
#pragma unroll
            for (int m = 0; m < 4; ++m) { bf16_t* rowp = base + (size_t)(row0 + ai * HALF + m * 16) * ldc + col0;
#pragma unroll
                for (int bj = 0; bj < 2; ++bj) { f32x4 v0 = acc[ai][bj][m][0] + bv[bj][0], v1 = acc[ai][bj][m][1] + bv[bj][1];
                    if (ACT == 1) { f32x2 a = gelu_pk((f32x2){v0[0], v0[1]}), b = gelu_pk((f32x2){v0[2], v0[3]}), c = gelu_pk((f32x2){v1[0], v1[1]}), d = gelu_pk((f32x2){v1[2], v1[3]});
                        v0 = (f32x4){a.x, a.y, b.x, b.y}; v1 = (f32x4){c.x, c.y, d.x, d.y}; }
                    v0 = v0 * sc; v1 = v1 * sc; u32x4 w; w.x = cvt_pk_bf16(v0[0], v0[1]); w.y = cvt_pk_bf16(v0[2], v0[3]); w.z = cvt_pk_bf16(v1[0], v1[1]); w.w = cvt_pk_bf16(v1[2], v1[3]);
                    *(u32x4*)(rowp + bj * HALF) = w; } }
    }
};

struct PanelStats {
    unsigned* xbuf;
    unsigned* cnt;
    unsigned* tmo;
    int ntn; float eps;
    unsigned code;
    __device__ __forceinline__ bool run(const f32x4 (&v)[2][2][4][2], const Unit& u, int wr, int wc, int fr, int fq, PG8_LAS unsigned char* lds, int wid, int lane) const {
        typedef float f32x2v __attribute__((ext_vector_type(2)));
        PG8_LAS f32x2v* P = (PG8_LAS f32x2v*)lds;
        PG8_LAS f32x2v* S = (PG8_LAS f32x2v*)(lds + 8192);
        PG8_LAS unsigned* flag = (PG8_LAS unsigned*)(lds + 8192 + 2048);
#pragma unroll
        for (int ai = 0; ai < 2; ++ai)
#pragma unroll
            for (int m = 0; m < 4; ++m) {
                float s = 0.f;
#pragma unroll
                for (int bj = 0; bj < 2; ++bj)
#pragma unroll
                    for (int n = 0; n < 2; ++n) { const f32x4 x = v[ai][bj][m][n]; s += (x[0] + x[1]) + (x[2] + x[3]); }
                s += __shfl_xor(s, 16); s += __shfl_xor(s, 32);
                const float mw = s * (1.0f / 64.0f); float q = 0.f;
#pragma unroll
                for (int bj = 0; bj < 2; ++bj)
#pragma unroll
                    for (int n = 0; n < 2; ++n) { const f32x4 d = v[ai][bj][m][n] - mw; q += (d[0] * d[0] + d[1] * d[1]) + (d[2] * d[2] + d[3] * d[3]); }
                q += __shfl_xor(q, 16); q += __shfl_xor(q, 32);
                if (fq == 0) P[(ai * HALF + wr * 64 + m * 16 + fr) * 4 + wc] = (f32x2v){mw, q};
            }
        asm volatile("s_waitcnt lgkmcnt(0)" ::: "memory"); __builtin_amdgcn_s_barrier(); asm volatile("" ::: "memory");
#if defined(BROKEN_EXCHANGE_NO_WAIT)
#warning BROKEN CONTROL BUILD: the row-statistics exchange does not wait; results are wrong by design
        if (blockIdx.x >= 64) { const long long t0_ = clock64(); while (clock64() - t0_ < 60000) __builtin_amdgcn_s_sleep(8); }
#endif
        const int row = wid * 32 + (lane & 31);
        if (lane < 32) {
            const f32x2v a = P[row * 4 + 0], b = P[row * 4 + 1], c = P[row * 4 + 2], d = P[row * 4 + 3];
            const float mt = (a.x + b.x + c.x + d.x) * 0.25f;
            const float da = a.x - mt, db = b.x - mt, dc = c.x - mt, dd = d.x - mt;
            const float m2 = (a.y + b.y) + (c.y + d.y) + 64.0f * ((da * da + db * db) + (dc * dc + dd * dd));
            unsigned long long* slot = (unsigned long long*)xbuf + ((size_t)(u.pm * BM + row) * 4 + u.pn);
            __hip_atomic_store(slot, ((unsigned long long)__float_as_uint(m2) << 32) | __float_as_uint(mt), __ATOMIC_RELAXED, __HIP_MEMORY_SCOPE_AGENT);
        }
        asm volatile("s_waitcnt vmcnt(0)" ::: "memory");
        if (lane == 0) __hip_atomic_fetch_add(cnt + 64 * u.pm, 1u, __ATOMIC_RELAXED, __HIP_MEMORY_SCOPE_AGENT);
        if (wid == 0) {
            bool dead = false; const unsigned long long t0 = __builtin_amdgcn_s_memrealtime(); const unsigned want = 8u * (unsigned)ntn;
            for (;;) {
#if defined(BROKEN_EXCHANGE_NO_WAIT)
                break;
#endif
                if ((unsigned)__builtin_amdgcn_readfirstlane(__hip_atomic_load(cnt + 64 * u.pm, __ATOMIC_RELAXED, __HIP_MEMORY_SCOPE_AGENT)) >= want) break;
                if (__builtin_amdgcn_s_memrealtime() - t0 > 2000000ull) {
                    if (lane == 0) { unsigned expect = 0u; __hip_atomic_compare_exchange_strong(tmo + 1, &expect, code | (unsigned)(u.pm & 0xff), __ATOMIC_RELAXED, __ATOMIC_RELAXED, __HIP_MEMORY_SCOPE_AGENT);
                                     __hip_atomic_store(tmo, 1u, __ATOMIC_RELAXED, __HIP_MEMORY_SCOPE_AGENT); }
                    dead = true; break; }
                __builtin_amdgcn_s_sleep(2);
            }
            __builtin_amdgcn_fence(__ATOMIC_ACQUIRE, "agent");
            if (lane == 0) flag[0] = dead ? 1u : 0u;
        }
        asm volatile("s_waitcnt vmcnt(0) lgkmcnt(0)" ::: "memory"); __builtin_amdgcn_s_barrier(); asm volatile("" ::: "memory");
        const bool bad = flag[0] != 0u;
        if (lane < 32) {
            const unsigned long long* slot = (const unsigned long long*)xbuf + (size_t)(u.pm * BM + row) * 4; float mt[4], m2[4]; float ms = 0.f;
#pragma unroll
            for (int t = 0; t < 4; ++t) { if (t < ntn) { const unsigned long long w = __hip_atomic_load(slot + t, __ATOMIC_RELAXED, __HIP_MEMORY_SCOPE_AGENT); mt[t] = __uint_as_float((unsigned)w); m2[t] = __uint_as_float((unsigned)(w >> 32)); } else { mt[t] = 0.f; m2[t] = 0.f; } ms += mt[t]; }
            const float mean = ms / (float)ntn; float q = 0.f;
#pragma unroll
            for (int t = 0; t < 4; ++t) if (t < ntn) { const float dm = mt[t] - mean; q += m2[t] + 256.0f * dm * dm; }
            S[row] = (f32x2v){mean, 1.0f / sqrtf(q / (256.0f * (float)ntn) + eps)};
        }
        asm volatile("s_waitcnt lgkmcnt(0)" ::: "memory"); __builtin_amdgcn_s_barrier(); asm volatile("" ::: "memory");
        return bad;
    }
};
struct EpiLnRes {
    static constexpr bool PERM = false, AFTER_DRAIN = true;
    const float* base; float* out; int ldc; const float* bias; PanelStats st; unsigned poison;
    __device__ __forceinline__ void fused(f32x4 (&acc)[2][2][4][2], const Unit& u, int wr, int wc, int fr, int fq, PG8_LAS unsigned char* lds, int wid, int lane) const {
        typedef float f32x2v __attribute__((ext_vector_type(2)));
        const PG8_LAS f32x2v* S = (const PG8_LAS f32x2v*)(lds + 8192);
        const int col0 = u.pn * BM + wc * 32 + 4 * fq;
#pragma unroll
        for (int bj = 0; bj < 2; ++bj)
#pragma unroll
            for (int n = 0; n < 2; ++n) { const f32x4 bv = bias ? *(const f32x4*)(bias + col0 + bj * HALF + n * 16) : (f32x4){0.f, 0.f, 0.f, 0.f};
#pragma unroll
                for (int ai = 0; ai < 2; ++ai)
#pragma unroll
                    for (int m = 0; m < 4; ++m) acc[ai][bj][m][n] += bv; }
        f32x4 pre[4][2][2];
#pragma unroll
        for (int m = 0; m < 4; ++m) { const size_t off = (size_t)(u.pm * BM + wr * 64 + m * 16 + fr) * ldc + col0;
#pragma unroll
            for (int bj = 0; bj < 2; ++bj)
#pragma unroll
                for (int n = 0; n < 2; ++n) pre[m][bj][n] = *(const f32x4*)(base + off + bj * HALF + n * 16); }
        const bool bad = st.run(acc, u, wr, wc, fr, fq, lds, wid, lane) || poison != 0u;
        const float qnan = __builtin_nanf("");
#pragma unroll
        for (int ai = 0; ai < 2; ++ai)
#pragma unroll
            for (int m = 0; m < 4; ++m) { const int r = ai * HALF + wr * 64 + m * 16 + fr; const f32x2v sr = S[r]; const size_t off = (size_t)(u.pm * BM + r) * ldc + col0;
#pragma unroll
                for (int bj = 0; bj < 2; ++bj)
#pragma unroll
                    for (int n = 0; n < 2; ++n) { const f32x4 bs = ai == 0 ? pre[m][bj][n] : *(const f32x4*)(base + off + bj * HALF + n * 16); f32x4 o = bs + (acc[ai][bj][m][n] - sr.x) * sr.y;
                        if (bad) o = (f32x4){qnan, qnan, qnan, qnan}; *(f32x4*)(out + off + bj * HALF + n * 16) = o; }
                if (m & 1) asm volatile("" ::: "memory"); }
    }
};
struct EpiLnResLn {
    static constexpr bool PERM = false, AFTER_DRAIN = true;
    const float* base; float* out; bf16_t* xn; int ldc; const float* bias; PanelStats st1, st2; unsigned poison;
    __device__ __forceinline__ void fused(f32x4 (&acc)[2][2][4][2], const Unit& u, int wr, int wc, int fr, int fq, PG8_LAS unsigned char* lds, int wid, int lane) const {
        typedef float f32x2v __attribute__((ext_vector_type(2))); typedef unsigned u32x2v __attribute__((ext_vector_type(2)));
        const PG8_LAS f32x2v* S = (const PG8_LAS f32x2v*)(lds + 8192);
        const int col0 = u.pn * BM + wc * 32 + 4 * fq;
#pragma unroll
        for (int bj = 0; bj < 2; ++bj)
#pragma unroll
            for (int n = 0; n < 2; ++n) { const f32x4 bv = bias ? *(const f32x4*)(bias + col0 + bj * HALF + n * 16) : (f32x4){0.f, 0.f, 0.f, 0.f};
#pragma unroll
                for (int ai = 0; ai < 2; ++ai)
#pragma unroll
                    for (int m = 0; m < 4; ++m) acc[ai][bj][m][n] += bv; }
        bool bad = st1.run(acc, u, wr, wc, fr, fq, lds, wid, lane) || poison != 0u;
        const float qnan = __builtin_nanf("");
#pragma unroll
        for (int ai = 0; ai < 2; ++ai)
#pragma unroll
            for (int m = 0; m < 4; ++m) { const int r = ai * HALF + wr * 64 + m * 16 + fr; const f32x2v sr = S[r]; const size_t off = (size_t)(u.pm * BM + r) * ldc + col0;
#pragma unroll
                for (int bj = 0; bj < 2; ++bj)
#pragma unroll
                    for (int n = 0; n < 2; ++n) { const f32x4 bs = *(const f32x4*)(base + off + bj * HALF + n * 16); acc[ai][bj][m][n] = bs + (acc[ai][bj][m][n] - sr.x) * sr.y; }
                asm volatile("" : "+v"(acc[ai][0][m][0]), "+v"(acc[ai][0][m][1]), "+v"(acc[ai][1][m][0]), "+v"(acc[ai][1][m][1]));
                if (m & 1) asm volatile("" ::: "memory"); }
        const bool bad1 = bad;
        bad = st2.run(acc, u, wr, wc, fr, fq, lds, wid, lane) || bad;
#pragma unroll
        for (int ai = 0; ai < 2; ++ai)
#pragma unroll
            for (int m = 0; m < 4; ++m) { const int r = ai * HALF + wr * 64 + m * 16 + fr; const f32x2v sr = S[r]; const size_t off = (size_t)(u.pm * BM + r) * ldc + col0;
#pragma unroll
                for (int bj = 0; bj < 2; ++bj)
#pragma unroll
                    for (int n = 0; n < 2; ++n) { const f32x4 x1 = acc[ai][bj][m][n]; *(f32x4*)(out + off + bj * HALF + n * 16) = bad1 ? (f32x4){qnan, qnan, qnan, qnan} : x1;
                        const f32x4 o = (x1 - sr.x) * sr.y; u32x2v w; w.x = cvt_pk_bf16(o[0], o[1]); w.y = cvt_pk_bf16(o[2], o[3]);
                        if (bad) { w.x = 0x7fc07fc0u; w.y = 0x7fc07fc0u; } *(u32x2v*)(xn + off + bj * HALF + n * 16) = w; }
                asm volatile("" ::: "memory"); }
    }
};

template <class Epi, class Sched, bool ALIGN_EPI = false, bool SP2 = false, bool GATHER = false>
__device__ __forceinline__ void gemm_phase(PG8_LAS unsigned char* lds, const Gemm g, const Sched& S, const Epi& E, PG8_LAS unsigned* toktab = nullptr, const int* glist = nullptr) {
    static_assert(!GATHER || SP2, "GATHER needs the SP2 loop (lgkmcnt(0)-only waits)");
    const int tid = threadIdx.x, wid = __builtin_amdgcn_readfirstlane(tid >> 6), lane = tid & 63, wr = wid >> 2, wc = wid & 3, fr = lane & 15, fq = lane >> 4;
    const int K = g.K, nt = K / BK;
    unsigned voffA[2], voffB[2];
#pragma unroll
    for (int i = 0; i < 2; ++i) { int R, C; stage_rc(tid * 16 + i * 8192, R, C); const int Rb = Epi::PERM ? ((R & ~31) + perm32(R & 31)) : R;
        voffA[i] = (unsigned)(R * K + C) * 2u; voffB[i] = (unsigned)(Rb * K + C) * 2u; }
    const size_t kstep = (size_t)(BK * 2);
    const size_t hstep = (size_t)HALF * K * 2;
    const size_t tstep = 2 * hstep;
    const unsigned ldsw = (unsigned)wid * 1024u;
    const int aoff = lds_byte(wr * 64 + fr, fq * 8), boff = lds_byte(wc * 32 + fr, fq * 8);
#define PG8_SA(b, h) (((b) * 2 + (h)) * HTB)
#define PG8_SB(b, h) ((4 + (b) * 2 + (h)) * HTB)
#define PG8_STAGE(bufoff, gbase, voff) do { _Pragma("unroll") for (int _i = 0; _i < 2; ++_i) \
        __builtin_amdgcn_global_load_lds((const unsigned*)((const char*)(gbase) + (voff)[_i]), (PG8_LAS unsigned*)(lds + (bufoff) + ldsw + _i * 8192), 16, 0, 0); } while (0)
#define PG8_STAGEA(bufoff, gbase, h) do { if constexpr (GATHER) { PG8_STAGE(bufoff, gbase, oA[h]); } else { PG8_STAGE(bufoff, (gbase) + (h) * hstep, voffA); } } while (0)
#define PG8_EXTRACT(U, bufsel) do { _Pragma("unroll") for (int h_ = 0; h_ < 2; ++h_) _Pragma("unroll") for (int i_ = 0; i_ < 2; ++i_) { const int row_ = h_ * HALF + rowA[i_]; \
        unsigned tk_ = toktab[(bufsel) * 512 + row_]; if (row_ >= (U).gn) tk_ = 0u; oA[h_][i_] = tk_ * (unsigned)(K * 2) + colA2[i_]; } } while (0)
#define PG8_TOKLOAD(U, bufsel) __builtin_amdgcn_global_load_lds((const unsigned*)(glist + (U).gl + tid), toktab + (bufsel) * 512 + wid * 64, 4, 0, 0)
#define PG8_LDA(dst, b, h) do { _Pragma("unroll") for (int m = 0; m < 4; ++m) _Pragma("unroll") for (int k = 0; k < 2; ++k) dst[m][k] = *(const PG8_LAS bf16x8*)(lds + PG8_SA(b, h) + aoff + m * 2048 + k * 1024); } while (0)
#define PG8_LDB(dst, b, h) do { _Pragma("unroll") for (int n = 0; n < 2; ++n) _Pragma("unroll") for (int k = 0; k < 2; ++k) dst[n][k] = *(const PG8_LAS bf16x8*)(lds + PG8_SB(b, h) + boff + n * 2048 + k * 1024); } while (0)
#define PG8_MMA(ai, bj, At, Bt) do { __builtin_amdgcn_s_setprio(1); _Pragma("unroll") for (int m = 0; m < 4; ++m) _Pragma("unroll") for (int n = 0; n < 2; ++n) _Pragma("unroll") for (int k = 0; k < 2; ++k) \
        acc[ai][bj][m][n] = __builtin_amdgcn_mfma_f32_16x16x32_bf16(Bt[n][k], At[m][k], acc[ai][bj][m][n], 0, 0, 0); __builtin_amdgcn_s_setprio(0); } while (0)
#define PG8_WAIT_V(n) asm volatile("s_waitcnt vmcnt(" #n ")" ::: "memory")
#define PG8_WAIT_L(n) asm volatile("s_waitcnt lgkmcnt(" #n ")" ::: "memory")
#define PG8_BAR __builtin_amdgcn_s_barrier()
#define PG8_SCHED __builtin_amdgcn_sched_barrier(0)
    Unit cur, nxt; int ui = 0;
    if (!S.next(0, cur)) return;
    f32x4 acc[2][2][4][2];
#pragma unroll
    for (int a = 0; a < 2; ++a)
#pragma unroll
        for (int b = 0; b < 2; ++b)
#pragma unroll
            for (int m = 0; m < 4; ++m)
#pragma unroll
                for (int n = 0; n < 2; ++n) acc[a][b][m][n] = (f32x4){0.f, 0.f, 0.f, 0.f};
    bf16x8 At[4][2], B0[2][2], B1[2][2];
    const char* cA = GATHER ? (const char*)g.A : (const char*)g.A + (size_t)cur.pm * tstep; const char* cB = (const char*)g.Bt + (size_t)cur.pn * tstep;
    S.a_ready(cur);
    unsigned oA[2][2] = {{0u, 0u}, {0u, 0u}}; int rowA[2] = {0, 0}; unsigned colA2[2] = {0u, 0u};
    if constexpr (GATHER) {
#pragma unroll
        for (int i = 0; i < 2; ++i) { int R, C; stage_rc(tid * 16 + i * 8192, R, C); rowA[i] = R; colA2[i] = (unsigned)C * 2u; }
        Unit n1; const bool h1 = S.next(1, n1);
        PG8_TOKLOAD(cur, 0); if (h1) PG8_TOKLOAD(n1, 1);
        PG8_WAIT_V(0); PG8_BAR; asm volatile("" ::: "memory");
        PG8_EXTRACT(cur, 0); PG8_WAIT_L(0);
    }
    if constexpr (SP2) {
        PG8_STAGE(PG8_SB(0, 0), cB, voffB); PG8_STAGE(PG8_SB(0, 1), cB + hstep, voffB); PG8_STAGEA(PG8_SA(0, 0), cA, 0); PG8_STAGEA(PG8_SA(0, 1), cA, 1);
        if (wr == 1) PG8_BAR;
        PG8_WAIT_V(2); PG8_BAR;
        PG8_STAGE(PG8_SB(1, 0), cB + kstep, voffB); PG8_STAGEA(PG8_SA(1, 0), cA + kstep, 0); PG8_STAGE(PG8_SB(1, 1), cB + hstep + kstep, voffB);
        PG8_WAIT_V(6); PG8_BAR;
    } else {
        PG8_STAGE(PG8_SB(0, 0), cB, voffB); PG8_STAGEA(PG8_SA(0, 0), cA, 0); PG8_STAGE(PG8_SB(0, 1), cB + hstep, voffB); PG8_STAGEA(PG8_SA(0, 1), cA, 1);
        if (wr == 1) PG8_BAR;
        PG8_WAIT_V(4); PG8_BAR;
        PG8_STAGE(PG8_SB(1, 0), cB + kstep, voffB); PG8_STAGEA(PG8_SA(1, 0), cA + kstep, 0); PG8_STAGE(PG8_SB(1, 1), cB + hstep + kstep, voffB);
        PG8_WAIT_V(6); PG8_BAR;
    }
    for (;;) {
        const bool has_next = S.next(ui + 1, nxt);
        const char* nA = (has_next && !GATHER) ? (const char*)g.A + (size_t)nxt.pm * tstep : cA; const char* nB = has_next ? (const char*)g.Bt + (size_t)nxt.pn * tstep : cB;
        for (int t = 0; t < nt; t += 2) {
            const bool last = (t == nt - 2);
            const char* a1 = cA + (size_t)(t + 1) * kstep;
            const char* a2 = last ? nA : cA + (size_t)(t + 2) * kstep; const char* b2 = last ? nB : cB + (size_t)(t + 2) * kstep;
            const char* a3 = a2 + kstep; const char* b3 = b2 + kstep;
            if (last && has_next) S.a_ready(nxt);
            if constexpr (SP2) {
            PG8_LDB(B0, 0, 0); PG8_LDB(B1, 0, 1); PG8_SCHED; PG8_LDA(At, 0, 0); PG8_STAGEA(PG8_SA(1, 1), a1, 1);
            if constexpr (GATHER) { if (last && has_next) { PG8_EXTRACT(nxt, (ui + 1) & 1); Unit n2; if (S.next(ui + 2, n2)) PG8_TOKLOAD(n2, ui & 1); } }
            PG8_WAIT_V(8); PG8_WAIT_L(0); PG8_BAR; PG8_MMA(0, 0, At, B0); PG8_MMA(0, 1, At, B1); PG8_BAR; PG8_SCHED;
            PG8_LDA(At, 0, 1); PG8_STAGE(PG8_SB(0, 0), b2, voffB); PG8_STAGE(PG8_SB(0, 1), b2 + hstep, voffB); PG8_STAGEA(PG8_SA(0, 0), a2, 0);
            PG8_WAIT_V(8); PG8_WAIT_L(0); PG8_BAR; PG8_MMA(1, 0, At, B0); PG8_MMA(1, 1, At, B1); PG8_BAR; PG8_SCHED;
            PG8_LDB(B0, 1, 0); PG8_LDB(B1, 1, 1); PG8_SCHED; PG8_LDA(At, 1, 0); PG8_STAGEA(PG8_SA(0, 1), a2, 1);
            PG8_WAIT_V(8); PG8_WAIT_L(0); PG8_BAR; PG8_MMA(0, 0, At, B0); PG8_MMA(0, 1, At, B1); PG8_BAR; PG8_SCHED;
            PG8_LDA(At, 1, 1); PG8_STAGE(PG8_SB(1, 0), b3, voffB); PG8_STAGE(PG8_SB(1, 1), b3 + hstep, voffB); PG8_STAGEA(PG8_SA(1, 0), a3, 0);
            PG8_WAIT_V(8); PG8_WAIT_L(0); PG8_BAR; PG8_MMA(1, 0, At, B0); PG8_MMA(1, 1, At, B1); PG8_BAR; PG8_SCHED;
            } else {
            PG8_LDB(B0, 0, 0); PG8_SCHED; PG8_LDA(At, 0, 0); PG8_STAGEA(PG8_SA(1, 1), a1, 1);
            PG8_WAIT_L(8); PG8_BAR; PG8_WAIT_L(0); PG8_MMA(0, 0, At, B0); PG8_BAR; PG8_SCHED;
            PG8_LDB(B1, 0, 1); PG8_STAGE(PG8_SB(0, 0), b2, voffB);
            PG8_BAR; PG8_WAIT_L(0); PG8_MMA(0, 1, At, B1); PG8_BAR;
            PG8_LDA(At, 0, 1); PG8_STAGEA(PG8_SA(0, 0), a2, 0);
            PG8_BAR; PG8_WAIT_L(0); PG8_MMA(1, 0, At, B0); PG8_BAR; PG8_SCHED;
            PG8_STAGE(PG8_SB(0, 1), b2 + hstep, voffB);
            PG8_WAIT_V(6); PG8_BAR; PG8_MMA(1, 1, At, B1); PG8_BAR;
            PG8_LDB(B0, 1, 0); PG8_SCHED; PG8_LDA(At, 1, 0); PG8_STAGEA(PG8_SA(0, 1), a2, 1);
            PG8_WAIT_L(8); PG8_BAR; PG8_WAIT_L(0); PG8_MMA(0, 0, At, B0); PG8_BAR; PG8_SCHED;
            PG8_LDB(B1, 1, 1); PG8_STAGE(PG8_SB(1, 0), b3, voffB);
            PG8_BAR; PG8_WAIT_L(0); PG8_MMA(0, 1, At, B1); PG8_BAR;
            PG8_LDA(At, 1, 1); PG8_STAGEA(PG8_SA(1, 0), a3, 0);
            PG8_BAR; PG8_WAIT_L(0); PG8_MMA(1, 0, At, B0); PG8_BAR; PG8_SCHED;
            PG8_STAGE(PG8_SB(1, 1), b3 + hstep, voffB);
            PG8_WAIT_V(6); PG8_BAR; PG8_MMA(1, 1, At, B1); PG8_BAR;
            }
        }
        if constexpr (ALIGN_EPI) { if (wr == 0) PG8_BAR; }
        if constexpr (!Epi::AFTER_DRAIN) { E(acc, cur, wr, wc, fr, fq); S.done(cur); }
        if (!has_next) break;
#pragma unroll
        for (int a = 0; a < 2; ++a)
#pragma unroll
            for (int b = 0; b < 2; ++b)
#pragma unroll
                for (int m = 0; m < 4; ++m)
#pragma unroll
                    for (int n = 0; n < 2; ++n) acc[a][b][m][n] = (f32x4){0.f, 0.f, 0.f, 0.f};
        cur = nxt; cA = nA; cB = nB; ++ui;
        if constexpr (ALIGN_EPI) { if (wr == 1) PG8_BAR; }
    }
    PG8_WAIT_V(0);
    if constexpr (!ALIGN_EPI) { if (wr == 0) PG8_BAR; }
    PG8_BAR;
    if constexpr (Epi::AFTER_DRAIN) { E.fused(acc, cur, wr, wc, fr, fq, lds, wid, lane); S.done(cur); }
#undef PG8_SA
#undef PG8_SB
#undef PG8_STAGE
#undef PG8_STAGEA
#undef PG8_EXTRACT
#undef PG8_TOKLOAD
#undef PG8_LDA
#undef PG8_LDB
#undef PG8_MMA
#undef PG8_WAIT_V
#undef PG8_WAIT_L
#undef PG8_BAR
#undef PG8_SCHED
}
}
namespace pg8 {
__device__ __forceinline__ float bf2f(unsigned short b) { return __uint_as_float((unsigned)b << 16); }
__device__ __forceinline__ float bflo(unsigned w) { return __uint_as_float(w << 16); }
__device__ __forceinline__ float bfhi(unsigned w) { return __uint_as_float(w & 0xffff0000u); }
__device__ __forceinline__ float sigmoidf_(float x) { return __builtin_amdgcn_rcpf(1.0f + __builtin_amdgcn_exp2f(-1.4426950408889634f * x)); }

struct EpiProj {
    static constexpr bool PERM = true, AFTER_DRAIN = false;
    bf16_t* QKV; bf16_t* Z; bf16_t* GT;
    __device__ __forceinline__ void operator()(const f32x4 (&acc)[2][2][4][2], const Unit& u, int wr, int wc, int fr, int fq) const {
        const int row0 = u.pm * BM + wr * 64 + fr; const int pn = u.pn;
        bf16_t* base; int ldc, colt, mode;
        if (pn < 9) { base = QKV; ldc = 2304; colt = pn * 256; mode = 0; }
        else if (pn < 15) { base = Z; ldc = 1536; colt = (pn - 9) * 256; mode = 1; }
        else { base = GT; ldc = 2048; colt = (pn - 15) * 256; mode = 2; }
        const int col0 = colt + wc * 32 + 8 * fq;
#pragma unroll
        for (int ai = 0; ai < 2; ++ai)
#pragma unroll
            for (int m = 0; m < 4; ++m) { bf16_t* rowp = base + (size_t)(row0 + ai * HALF + m * 16) * ldc + col0;
#pragma unroll
                for (int bj = 0; bj < 2; ++bj) { f32x4 v0 = acc[ai][bj][m][0], v1 = acc[ai][bj][m][1];
                    if (mode == 1) { f32x2 a = gelu_pk((f32x2){v0[0], v0[1]}), b = gelu_pk((f32x2){v0[2], v0[3]}), c = gelu_pk((f32x2){v1[0], v1[1]}), d = gelu_pk((f32x2){v1[2], v1[3]});
                        v0 = (f32x4){a.x, a.y, b.x, b.y}; v1 = (f32x4){c.x, c.y, d.x, d.y}; }
                    else if (mode == 2) {
#pragma unroll
                        for (int j = 0; j < 4; ++j) { v0[j] = sigmoidf_(v0[j]); v1[j] = sigmoidf_(v1[j]); } }
                    u32x4 w; w.x = cvt_pk_bf16(v0[0], v0[1]); w.y = cvt_pk_bf16(v0[2], v0[3]); w.z = cvt_pk_bf16(v1[0], v1[1]); w.w = cvt_pk_bf16(v1[2], v1[3]);
                    *(u32x4*)(rowp + bj * HALF) = w; } }
    }
};

template <bool ADD> struct EpiGate {
    static constexpr bool PERM = true, AFTER_DRAIN = false;
    const bf16_t* SG; int sgoff; const bf16_t* M1in; bf16_t* O;
    __device__ __forceinline__ void operator()(const f32x4 (&acc)[2][2][4][2], const Unit& u, int wr, int wc, int fr, int fq) const {
        const int row0 = u.pm * BM + wr * 64 + fr; const int col0 = u.pn * BM + wc * 32 + 8 * fq;
#pragma unroll
        for (int ai = 0; ai < 2; ++ai)
#pragma unroll
            for (int m = 0; m < 4; ++m) { const size_t r = (size_t)(row0 + ai * HALF + m * 16);
#pragma unroll
                for (int bj = 0; bj < 2; ++bj) { const int c = col0 + bj * HALF;
                    const u32x4 s = *(const u32x4*)(SG + r * 2048 + sgoff + c);
                    f32x4 v0 = acc[ai][bj][m][0], v1 = acc[ai][bj][m][1];
                    v0[0] *= bflo(s.x); v0[1] *= bfhi(s.x); v0[2] *= bflo(s.y); v0[3] *= bfhi(s.y); v1[0] *= bflo(s.z); v1[1] *= bfhi(s.z); v1[2] *= bflo(s.w); v1[3] *= bfhi(s.w);
                    if (ADD) { const u32x4 p = *(const u32x4*)(M1in + r * 1024 + c);
                        v0[0] += bflo(p.x); v0[1] += bfhi(p.x); v0[2] += bflo(p.y); v0[3] += bfhi(p.y); v1[0] += bflo(p.z); v1[1] += bfhi(p.z); v1[2] += bflo(p.w); v1[3] += bfhi(p.w); }
                    u32x4 w; w.x = cvt_pk_bf16(v0[0], v0[1]); w.y = cvt_pk_bf16(v0[2], v0[3]); w.z = cvt_pk_bf16(v1[0], v1[1]); w.w = cvt_pk_bf16(v1[2], v1[3]);
                    *(u32x4*)(O + r * 1024 + c) = w; } }
    }
};

struct EpiResid {
    static constexpr bool PERM = false, AFTER_DRAIN = false;
    const float* X; float* OUT; bf16_t* XB;
    __device__ __forceinline__ void operator()(const f32x4 (&acc)[2][2][4][2], const Unit& u, int wr, int wc, int fr, int fq) const {
        typedef unsigned u32x2v __attribute__((ext_vector_type(2)));
        const int row0 = u.pm * BM + wr * 64 + fr; const int col0 = u.pn * BM + wc * 32 + 4 * fq;
#pragma unroll
        for (int ai = 0; ai < 2; ++ai)
#pragma unroll
            for (int m = 0; m < 4; ++m) { const size_t off = (size_t)(row0 + ai * HALF + m * 16) * 1024 + col0;
#pragma unroll
                for (int bj = 0; bj < 2; ++bj)
#pragma unroll
                    for (int n = 0; n < 2; ++n) { const size_t o = off + bj * HALF + n * 16; const f32x4 r = *(const f32x4*)(X + o) + acc[ai][bj][m][n];
                        *(f32x4*)(OUT + o) = r; u32x2v w; w.x = cvt_pk_bf16(r[0], r[1]); w.y = cvt_pk_bf16(r[2], r[3]); *(u32x2v*)(XB + o) = w; } }
    }
};

struct EpiSwiglu {
    static constexpr bool PERM = true, AFTER_DRAIN = false;
    const float* RS; const float* BGU; bf16_t* ACT;
    __device__ __forceinline__ void operator()(const f32x4 (&acc)[2][2][4][2], const Unit& u, int wr, int wc, int fr, int fq) const {
        const int ct = u.pn & 7; const int cw = wc * 32 + 8 * fq;
        const float* bg = BGU + (size_t)u.e * 2048 + ct * 128 + cw; const float* bu = bg + 1024;
        const f32x4 bg0 = *(const f32x4*)bg, bg1 = *(const f32x4*)(bg + 4), bu0 = *(const f32x4*)bu, bu1 = *(const f32x4*)(bu + 4);
#pragma unroll
        for (int ai = 0; ai < 2; ++ai)
#pragma unroll
            for (int m = 0; m < 4; ++m) { const int rr = ai * HALF + wr * 64 + m * 16 + fr; const float rs = RS[u.gl + rr];
                f32x4 g0 = acc[ai][0][m][0] * rs + bg0, g1 = acc[ai][0][m][1] * rs + bg1, p0 = acc[ai][1][m][0] * rs + bu0, p1 = acc[ai][1][m][1] * rs + bu1;
                float o[8];
#pragma unroll
                for (int j = 0; j < 4; ++j) { float g = fminf(g0[j], 7.0f), p = fminf(fmaxf(p0[j], -7.0f), 7.0f); o[j] = (p + 1.0f) * (g * sigmoidf_(1.702f * g));
                    g = fminf(g1[j], 7.0f); p = fminf(fmaxf(p1[j], -7.0f), 7.0f); o[4 + j] = (p + 1.0f) * (g * sigmoidf_(1.702f * g)); }
                u32x4 w; w.x = cvt_pk_bf16(o[0], o[1]); w.y = cvt_pk_bf16(o[2], o[3]); w.z = cvt_pk_bf16(o[4], o[5]); w.w = cvt_pk_bf16(o[6], o[7]);
                *(u32x4*)(ACT + (size_t)(u.ob + rr) * 1024 + ct * 128 + cw) = w; }
    }
};

struct EpiDown {
    static constexpr bool PERM = true, AFTER_DRAIN = false;
    const float* GW; const float* BD; bf16_t* Y;
    __device__ __forceinline__ void operator()(const f32x4 (&acc)[2][2][4][2], const Unit& u, int wr, int wc, int fr, int fq) const {
        const int ct = u.pn & 3; const int col0 = ct * 256 + wc * 32 + 8 * fq;
        const float* bd = BD + (size_t)u.e * 1024 + col0;
        f32x4 bv[2][2];
#pragma unroll
        for (int bj = 0; bj < 2; ++bj)
#pragma unroll
            for (int n = 0; n < 2; ++n) bv[bj][n] = *(const f32x4*)(bd + bj * HALF + 4 * n);
#pragma unroll
        for (int ai = 0; ai < 2; ++ai)
#pragma unroll
            for (int m = 0; m < 4; ++m) { const int rr = ai * HALF + wr * 64 + m * 16 + fr; const float gw = GW[u.gl + rr];
#pragma unroll
                for (int bj = 0; bj < 2; ++bj) { const f32x4 v0 = (acc[ai][bj][m][0] + bv[bj][0]) * gw, v1 = (acc[ai][bj][m][1] + bv[bj][1]) * gw;
                    u32x4 w; w.x = cvt_pk_bf16(v0[0], v0[1]); w.y = cvt_pk_bf16(v0[2], v0[3]); w.z = cvt_pk_bf16(v1[0], v1[1]); w.w = cvt_pk_bf16(v1[2], v1[3]);
                    *(u32x4*)(Y + (size_t)(u.ob + rr) * 1024 + col0 + bj * HALF) = w; } }
    }
};

struct MoeOrder {
    volatile PG8_LAS int* mpt; volatile PG8_LAS int* mcnt; int nct, G, c, total, TT;
    __device__ __forceinline__ void init(volatile PG8_LAS int* mpt_, volatile PG8_LAS int* mcnt_, int nct_, int G_, int c_, int TT_) {
        mpt = mpt_; mcnt = mcnt_; nct = nct_; G = G_; c = c_; TT = TT_; total = __builtin_amdgcn_readfirstlane(mpt_[32]) * nct_; }
    __device__ __forceinline__ bool next(int i, Unit& u) const {
        const int L = i * G + c; if (L >= total) return false;
        const int rtg = L / nct, ct = L - rtg * nct; int e = 0;
#pragma unroll 1
        for (int j = 1; j < 32; ++j) { if (__builtin_amdgcn_readfirstlane(mpt[j]) <= rtg) e = j; }
        const int rt = rtg - __builtin_amdgcn_readfirstlane(mpt[e]);
        u.pm = rtg; u.pn = e * nct + ct; u.e = e; u.ob = rtg * 256; u.gl = e * TT + rt * 256; u.gn = __builtin_amdgcn_readfirstlane(mcnt[e]) - rt * 256; return true;
    }
    __device__ __forceinline__ void a_ready(const Unit&) const {}
    __device__ __forceinline__ void done(const Unit&) const {}
};
}
#ifndef PG8_SP2
#define PG8_SP2 true
#endif
#ifndef PG8_ALIGN
#define PG8_ALIGN true
#endif
#ifndef MK_PER_PHASE
#define MK_PER_PHASE 0
#endif
constexpr int NWAVES = 8;
constexpr int BATCH = 16, SEQ = 2048, DM = 1024, T = BATCH * SEQ;
constexpr int NH = 12, AW = 768, INW = 5888, NE = 32;
constexpr float EPS = 1e-6f;
constexpr int N_PHASES = 11;
constexpr size_t MiB = 1u << 20;
constexpr size_t WS_CTL = 0, CTL_ZERO_BYTES = 1 * MiB;
constexpr size_t WS_WIN = 2 * MiB;
constexpr size_t WS_WA = 14 * MiB, WS_WB = 16 * MiB;
constexpr size_t WS_WOUT = 18 * MiB;
constexpr size_t WS_WSP = 20 * MiB;
constexpr size_t WS_WRH = 21 * MiB, WS_WRL = 21 * MiB + 65536;
constexpr size_t WS_ROPE = 22 * MiB;
constexpr size_t WS_TE = 30 * MiB, WS_TP = 30 * MiB + 524288;
constexpr size_t WS_WGU = 32 * MiB;
constexpr size_t WS_WD = 160 * MiB;
constexpr size_t WS_XN = 224 * MiB;
constexpr size_t WS_QKV = 288 * MiB;
constexpr size_t WS_Z = 432 * MiB;
constexpr size_t WS_GT = 528 * MiB;
constexpr size_t WS_ATT = 656 * MiB, WS_SGU = 704 * MiB;
constexpr size_t WS_LSE = 752 * MiB;
constexpr size_t WS_ACT = 288 * MiB;
constexpr size_t WS_Y = 560 * MiB;
constexpr size_t WS_LIST = 832 * MiB, WS_GWL = 837 * MiB, WS_RS = 842 * MiB;
constexpr size_t WS_END = 848 * MiB;
constexpr int CW_TMO = 0, CW_CODE = 1, CW_BAR = 4096, CW_CNT = 8192;
constexpr int RING_OFF = 0, RING_BYTES = 131072;
constexpr int LDSCTL_OFF = RING_BYTES, MISC_OFF = LDSCTL_OFF + 320;
constexpr int TOKTAB_OFF = LDSCTL_OFF + 1024;
constexpr int MOE_OFF = TOKTAB_OFF + 4096;
constexpr int LDS_BYTES = 147456;
static_assert(MOE_OFF + 1024 <= LDS_BYTES, "LDS map");
#define GAS __attribute__((address_space(1)))
#define LAS __attribute__((address_space(3)))
typedef unsigned short bf16;
typedef unsigned v4u __attribute__((ext_vector_type(4)));
typedef float f32x4 __attribute__((ext_vector_type(4)));
typedef short bf16x8 __attribute__((ext_vector_type(8)));
typedef GAS unsigned gu32;
typedef GAS unsigned long long gu64;
#define RLX_AGENT __ATOMIC_RELAXED, __HIP_MEMORY_SCOPE_AGENT
#define LDS_WAIT() asm volatile("s_waitcnt lgkmcnt(0)" ::: "memory")
#define VM_WAIT() asm volatile("s_waitcnt vmcnt(0)" ::: "memory")
__device__ __forceinline__ unsigned long long rt() { return __builtin_amdgcn_s_memrealtime(); }
__device__ __forceinline__ unsigned f2bf(float f) { unsigned u = __builtin_bit_cast(unsigned, f); return (u + 0x7fffu + ((u >> 16) & 1u)) >> 16; }
__device__ __forceinline__ unsigned pk2(float lo, float hi) { return f2bf(lo) | (f2bf(hi) << 16); }

#define XB_TMO      128
#define XB_XCNT(j)  (256  + 64 * (j))
#define XB_XSUB(j)  (1280 + 64 * (j))
#define XB_XGEN(j)  (2304 + 64 * (j))
#define XB_TOP      3328
#define XB_TOPGEN   3392
#define XCD_BAR_WORDS 3456
#define XB_SPIN_CAP (1u << 18)

__device__ __forceinline__ unsigned xb_ld(unsigned* p)              { return __hip_atomic_load(p, __ATOMIC_RELAXED, __HIP_MEMORY_SCOPE_AGENT); }
__device__ __forceinline__ unsigned xb_add(unsigned* p, unsigned v) { return __hip_atomic_fetch_add(p, v, __ATOMIC_RELAXED, __HIP_MEMORY_SCOPE_AGENT); }
__device__ __forceinline__ unsigned xb_xcc_id() { return (unsigned)__builtin_amdgcn_s_getreg((3 << 11) | 20) & 0xFu; }
#define XB_SPIN(cond, bar) do { unsigned _sp = 0; while (cond) { __builtin_amdgcn_s_sleep(1); \
    if ((++_sp & 255u) == 0u) { if (xb_ld(&(bar)[XB_TMO])) break; if (_sp > XB_SPIN_CAP) { atomicAdd(&(bar)[XB_TMO], 1u); break; } } } } while (0)

struct XcdBarrier {
    unsigned* bar; unsigned x;
    volatile LAS unsigned* st;
};

__device__ __forceinline__ XcdBarrier xcd_barrier_post(unsigned* bar, volatile LAS unsigned* st) {
    XcdBarrier b; b.bar = bar; b.x = xb_xcc_id(); b.st = st;
    if (threadIdx.x == 0) (void)xb_add(&bar[XB_XCNT(b.x)], 1u);
    return b;
}
__device__ __forceinline__ void xcd_barrier_complete(unsigned* bar, unsigned x, unsigned& nloc, unsigned& nx) {
    const unsigned G = gridDim.x * gridDim.y * gridDim.z;
    unsigned sum, cnt, mine, sp = 0u;
    for (;;) {
        sum = 0u; cnt = 0u; mine = 0u;
#pragma unroll
        for (unsigned j = 0; j < 16; ++j) { const unsigned c = xb_ld(&bar[XB_XCNT(j)]); sum += c; cnt += (c > 0u) ? 1u : 0u; mine = (j == x) ? c : mine; }
        if (sum == G) break;
        __builtin_amdgcn_s_sleep(1);
        if ((++sp & 255u) == 0u) { if (xb_ld(&bar[XB_TMO])) break; if (sp > XB_SPIN_CAP) { atomicAdd(&bar[XB_TMO], 1u); break; } }
    }
    nloc = mine > 0u ? mine : 1u; nx = cnt > 0u ? cnt : 1u;
}

__device__ __forceinline__ void xcd_barrier(const XcdBarrier& b) {
    asm volatile("s_waitcnt vmcnt(0)" ::: "memory");
    __syncthreads();
    if (threadIdx.x == 0) {
        unsigned* bar = b.bar;
        __builtin_amdgcn_s_waitcnt(0);
        unsigned nloc = b.st[0], nx = b.st[1];
        if (nloc == 0u) { xcd_barrier_complete(bar, b.x, nloc, nx); b.st[0] = nloc; b.st[1] = nx; }
        const unsigned old = xb_add(&bar[XB_XSUB(b.x)], 1u);
        const unsigned gen = old / nloc;
        if (old + 1u == (gen + 1u) * nloc) {
            __builtin_amdgcn_fence(__ATOMIC_RELEASE, "agent");
            asm volatile("s_waitcnt vmcnt(0)" ::: "memory");
            const unsigned og = xb_add(&bar[XB_TOP], 1u);
            const unsigned tg = og / nx;
            if (og + 1u == (tg + 1u) * nx) xb_add(&bar[XB_TOPGEN], 1u);
            else XB_SPIN(xb_ld(&bar[XB_TOPGEN]) == tg, bar);
            __builtin_amdgcn_fence(__ATOMIC_ACQUIRE, "agent");
            xb_add(&bar[XB_XGEN(b.x)], 1u);
            asm volatile("s_waitcnt vmcnt(0)" ::: "memory");
        } else {
            XB_SPIN(xb_ld(&bar[XB_XGEN(b.x)]) == gen, bar);
            __builtin_amdgcn_fence(__ATOMIC_ACQUIRE, "agent");
            asm volatile("s_waitcnt vmcnt(0)" ::: "memory");
        }
    }
    __syncthreads();
}
typedef short v4i16_t __attribute__((ext_vector_type(4)));
typedef unsigned u32x2 __attribute__((ext_vector_type(2)));
struct Frame {
    LAS unsigned char* lds;
    volatile LAS unsigned* MISC;
    gu32* ctl;
    int tid, lane, wave;
    int vcu, G;
    const float* x; const int* positions; const float *norm1_g, *w_in, *q_norm_g, *k_norm_g, *sgu_ln_g, *sgu_ln_b, *w_spatial, *b_spatial, *w_branch_a, *w_branch_b, *w_out, *norm2_g,
        *w_router, *b_router, *w_gate_up, *b_gate_up, *w_down, *b_down;
    float* out;
    bf16 *WIN, *WA, *WB, *WOUT, *WSP, *WRH, *WRL, *WGU, *WD, *XN, *QKV, *Z, *GT, *ATT, *SGU, *ACT, *Y;
    float *ROPE, *LSE, *GWL, *RS; int *TE, *TP, *LIST;
};
__device__ __forceinline__ float wave_sum(float v) {
#pragma unroll
    for (int o = 1; o < 64; o <<= 1) v += __shfl_xor(v, o);
    return v;
}
__device__ __forceinline__ float bf_lo(unsigned w) { return __uint_as_float(w << 16); }
__device__ __forceinline__ float bf_hi(unsigned w) { return __uint_as_float(w & 0xffff0000u); }
__device__ __forceinline__ f32x4 mfma16(bf16x8 a, bf16x8 b, f32x4 c) { return __builtin_amdgcn_mfma_f32_16x16x32_bf16(a, b, c, 0, 0, 0); }

__device__ __forceinline__ void p0_transpose_item(const float* W, int N, bf16* WT, int KT, int k0, int n0, int drow0, const float* kscale, LAS float* scr, int lane) {
#pragma unroll 8
    for (int i = 0; i < 32; ++i) { const int kk = 2 * i + (lane >> 5); float v = W[(size_t)(k0 + kk) * N + n0 + (lane & 31)]; if (kscale) v *= kscale[k0 + kk]; scr[kk * 33 + (lane & 31)] = v; }
    LDS_WAIT(); asm volatile("" ::: "memory");
    const int c = lane & 7;
#pragma unroll
    for (int j = 0; j < 4; ++j) { const int n = (lane >> 3) + 8 * j; const LAS float* s = scr + (8 * c) * 33 + n;
        v4u o; o.x = pk2(s[0 * 33], s[1 * 33]); o.y = pk2(s[2 * 33], s[3 * 33]); o.z = pk2(s[4 * 33], s[5 * 33]); o.w = pk2(s[6 * 33], s[7 * 33]);
        *(GAS v4u*)(WT + (size_t)(drow0 + n) * KT + k0 + 8 * c) = o; }
    LDS_WAIT(); asm volatile("" ::: "memory");
}
__device__ __forceinline__ void p0_prologue(Frame& F) {
    LAS float* scr = (LAS float*)(F.lds + RING_OFF + F.wave * 16384);
    const int gw = F.vcu * NWAVES + F.wave, NGW = F.G * NWAVES, lane = F.lane;
    constexpr int I_IN = 16 * 184, I_A = 12 * 32, I_OUT = 16 * 32, I_GU = 32 * 16 * 64, I_D = 32 * 16 * 32;
    constexpr int NITEMS = I_IN + 2 * I_A + I_OUT + I_GU + I_D;
    for (int it = gw; it < NITEMS; it += NGW) {
        int r = it;
        if (r < I_IN) { const int kb = r / 184, nb = r % 184; p0_transpose_item(F.w_in, INW, F.WIN, 1024, 64 * kb, 32 * nb, 32 * nb, nullptr, scr, lane); continue; } r -= I_IN;
        if (r < I_A) { const int kb = r / 32, nb = r % 32; p0_transpose_item(F.w_branch_a, 1024, F.WA, 768, 64 * kb, 32 * nb, 32 * nb, nullptr, scr, lane); continue; } r -= I_A;
        if (r < I_A) { const int kb = r / 32, nb = r % 32; p0_transpose_item(F.w_branch_b, 1024, F.WB, 768, 64 * kb, 32 * nb, 32 * nb, nullptr, scr, lane); continue; } r -= I_A;
        if (r < I_OUT) { const int kb = r / 32, nb = r % 32; p0_transpose_item(F.w_out, 1024, F.WOUT, 1024, 64 * kb, 32 * nb, 32 * nb, nullptr, scr, lane); continue; } r -= I_OUT;
        if (r < I_GU) { const int e = r >> 10, q = r & 1023, kb = q >> 6, nb = q & 63, n0 = 32 * nb;
            const int nn = n0 & 1023, drow = e * 2048 + (nn >> 7) * 256 + (n0 >= 1024 ? 128 : 0) + (nn & 127);
            p0_transpose_item(F.w_gate_up + (size_t)e * 1024 * 2048, 2048, F.WGU, 1024, 64 * kb, n0, drow, F.norm2_g, scr, lane); continue; } r -= I_GU;
        { const int e = r >> 9, q = r & 511, kb = q >> 5, nb = q & 31;
            p0_transpose_item(F.w_down + (size_t)e * 1024 * 1024, 1024, F.WD, 1024, 64 * kb, 32 * nb, e * 1024 + 32 * nb, nullptr, scr, lane); }
    }
    for (int m = gw; m < T; m += NGW) {
        const GAS f32x4* xr = (const GAS f32x4*)(F.x + (size_t)m * DM) + lane; const GAS f32x4* gr = (const GAS f32x4*)F.norm1_g + lane;
        f32x4 v[4]; float s = 0.f;
#pragma unroll
        for (int j = 0; j < 4; ++j) { v[j] = xr[64 * j]; s += (v[j].x * v[j].x + v[j].y * v[j].y) + (v[j].z * v[j].z + v[j].w * v[j].w); }
        const float rstd = 1.0f / sqrtf(wave_sum(s) * (1.f / DM) + EPS);
        GAS unsigned long long* o8 = (GAS unsigned long long*)(F.XN + (size_t)m * DM) + lane;
#pragma unroll
        for (int j = 0; j < 4; ++j) { const f32x4 gg = gr[64 * j]; o8[64 * j] = (unsigned long long)pk2(v[j].x * rstd * gg.x, v[j].y * rstd * gg.y) | ((unsigned long long)pk2(v[j].z * rstd * gg.z, v[j].w * rstd * gg.w) << 32); }
    }
    const int gt = F.vcu * (NWAVES * 64) + F.tid, NGT = F.G * NWAVES * 64;
    for (int i = gt; i < 12 * 128 * 128; i += NGT) { const int s = i & 127, t = (i >> 7) & 127; F.WSP[i] = (bf16)((s <= t) ? f2bf(F.w_spatial[i]) : 0u); }
    for (int i = gt; i < T * 32; i += NGT) { const int t = i >> 5, f = i & 31;
        const float inv = powf(10000.0f, -(float)f * (1.0f / 32.0f)); const float ang = (float)F.positions[t] * inv;
        const double rev = (double)ang * 0.15915494309189535; const float fr = (float)(rev - floor(rev));
        F.ROPE[2 * i] = __builtin_amdgcn_cosf(fr); F.ROPE[2 * i + 1] = __builtin_amdgcn_sinf(fr); }
    for (int i = gt; i < 32 * 1024; i += NGT) { const int e = i >> 10, k = i & 1023; const float v = F.norm2_g[k] * F.w_router[k * 32 + e];
        const unsigned h = f2bf(v); const float hf = __uint_as_float(h << 16); F.WRH[i] = (bf16)h; F.WRL[i] = (bf16)f2bf(v - hf); }
}

__device__ __forceinline__ void p1b_qknorm(Frame& F) {
    const int gw = F.vcu * NWAVES + F.wave, NGW = F.G * NWAVES, lane = F.lane, c = lane & 7;
    for (int t = gw; t < T; t += NGW) {
        bf16* row = F.QKV + (size_t)t * 2304; const float* tab = F.ROPE + (size_t)t * 64;
#pragma unroll
        for (int it = 0; it < 3; ++it) {
            const int hr = it * 8 + (lane >> 3);
            GAS v4u* p = (GAS v4u*)(row + hr * 64 + c * 8); const v4u raw = *p;
            float v[8] = {bf_lo(raw.x), bf_hi(raw.x), bf_lo(raw.y), bf_hi(raw.y), bf_lo(raw.z), bf_hi(raw.z), bf_lo(raw.w), bf_hi(raw.w)};
            float ss = 0.f;
#pragma unroll
            for (int j = 0; j < 8; ++j) ss += v[j] * v[j];
            ss += __shfl_xor(ss, 1); ss += __shfl_xor(ss, 2); ss += __shfl_xor(ss, 4);
            const float rstd = 1.0f / sqrtf(ss * (1.f / 64.f) + EPS);
            const float* gg = ((hr < 12) ? F.q_norm_g : F.k_norm_g) + c * 8;
            float o[8];
#pragma unroll
            for (int j = 0; j < 8; ++j) v[j] = v[j] * rstd * gg[j];
#pragma unroll
            for (int j = 0; j < 8; ++j) { const float pr = __shfl_xor(v[j], 4); const float cs = tab[2 * ((c & 3) * 8 + j)], sn = tab[2 * ((c & 3) * 8 + j) + 1];
                o[j] = (c < 4) ? (v[j] * cs - pr * sn) : (v[j] * cs + pr * sn); }
            v4u w; w.x = pk2(o[0], o[1]); w.y = pk2(o[2], o[3]); w.z = pk2(o[4], o[5]); w.w = pk2(o[6], o[7]);
            *p = w;
        }
    }
}

__device__ __forceinline__ void p2_attention(Frame& F) {
    LAS unsigned char* Ql = F.lds; LAS unsigned char* Kl = F.lds + 16384; LAS unsigned char* Vl = F.lds + 49152;
    const int tid = F.tid, lane = F.lane, w = F.wave, c16 = lane & 15, g = lane >> 4;
    for (int unit = F.vcu; unit < BATCH * NH * 16; unit += F.G) {
        const int b = unit / 192, rem = unit - b * 192, h = rem >> 4, blk = rem & 15;
        const int dsh = 2 * (h >> 2), nbk = 16 >> dsh, r = blk >> (4 - dsh), n = blk & (nbk - 1);
        const bf16* base = F.QKV + (size_t)b * SEQ * 2304 + h * 64;
        v4u qv[2], kv[4], vv[4];
#pragma unroll
        for (int i = 0; i < 2; ++i) { const int idx = tid + i * 512, row = idx >> 3, c = idx & 7; const int s = ((128 * n + row) << dsh) + r; qv[i] = *(const GAS v4u*)(base + (size_t)s * 2304 + c * 8); }
#pragma unroll
        for (int i = 0; i < 4; ++i) { const int idx = tid + i * 512, row = idx >> 3, c = idx & 7; const int mk = 128 * (n - 1) + row;
            if (mk >= 0) { const int s = (mk << dsh) + r; const bf16* p = base + (size_t)s * 2304 + c * 8; kv[i] = *(const GAS v4u*)(p + 768); vv[i] = *(const GAS v4u*)(p + 1536); }
            else { kv[i] = (v4u){0u, 0u, 0u, 0u}; vv[i] = (v4u){0u, 0u, 0u, 0u}; } }
#pragma unroll
        for (int i = 0; i < 2; ++i) { const int idx = tid + i * 512, row = idx >> 3, c = idx & 7; *(LAS v4u*)(Ql + row * 128 + ((c ^ ((row >> 1) & 7)) << 4)) = qv[i]; }
#pragma unroll
        for (int i = 0; i < 4; ++i) { const int idx = tid + i * 512, row = idx >> 3, c = idx & 7;
            *(LAS v4u*)(Kl + row * 128 + ((c ^ ((row >> 1) & 7)) << 4)) = kv[i];
            *(LAS v4u*)(Vl + row * 128 + ((((c >> 1) ^ ((row >> 1) & 3))) << 5) + ((c & 1) << 4)) = vv[i]; }
        __syncthreads();
        {
            const int qrow = 16 * w + c16;
            bf16x8 Qb[2];
#pragma unroll
            for (int ks = 0; ks < 2; ++ks) { const int ch = g + 4 * ks; Qb[ks] = *(const LAS bf16x8*)(Ql + qrow * 128 + ((ch ^ ((qrow >> 1) & 7)) << 4)); }
            f32x4 S[10];
#pragma unroll
            for (int tt = 0; tt < 9; ++tt) { const int krow = 16 * (w + tt) + c16; f32x4 a = (f32x4){0.f, 0.f, 0.f, 0.f};
#pragma unroll
                for (int ks = 0; ks < 2; ++ks) { const int ch = g + 4 * ks; const bf16x8 Ka = *(const LAS bf16x8*)(Kl + krow * 128 + ((ch ^ ((krow >> 1) & 7)) << 4)); a = mfma16(Ka, Qb[ks], a); }
                S[tt] = a; }
            S[9] = (f32x4){0.f, 0.f, 0.f, 0.f};
            float mx = -3.0e38f;
#pragma unroll
            for (int tt = 0; tt < 9; ++tt)
#pragma unroll
                for (int rg = 0; rg < 4; ++rg) { const int j = 16 * (w + tt) + 4 * g + rg, dist = 128 + qrow - j, mk = 128 * (n - 1) + j;
                    const bool valid = (dist >= 0) && (dist <= 128) && (mk >= 0); const float s = valid ? S[tt][rg] * 0.125f : -1.0e30f; S[tt][rg] = s; mx = fmaxf(mx, s); }
            mx = fmaxf(mx, __shfl_xor(mx, 16)); mx = fmaxf(mx, __shfl_xor(mx, 32));
            float sum = 0.f;
#pragma unroll
            for (int tt = 0; tt < 9; ++tt)
#pragma unroll
                for (int rg = 0; rg < 4; ++rg) { const float p = __builtin_amdgcn_exp2f((S[tt][rg] - mx) * 1.4426950408889634f); S[tt][rg] = p; sum += p; }
            sum += __shfl_xor(sum, 16); sum += __shfl_xor(sum, 32);
            f32x4 O[4];
#pragma unroll
            for (int dt = 0; dt < 4; ++dt) O[dt] = (f32x4){0.f, 0.f, 0.f, 0.f};
            const int q4 = (lane >> 2) & 3, p4 = lane & 3;
#pragma unroll
            for (int kp = 0; kp < 5; ++kp) { const int t0 = w + 2 * kp; int t1 = w + 2 * kp + 1; t1 = t1 > 15 ? 15 : t1;
                v4u pw; pw.x = pk2(S[2 * kp][0], S[2 * kp][1]); pw.y = pk2(S[2 * kp][2], S[2 * kp][3]); pw.z = pk2(S[2 * kp + 1][0], S[2 * kp + 1][1]); pw.w = pk2(S[2 * kp + 1][2], S[2 * kp + 1][3]);
                const bf16x8 Pb = __builtin_bit_cast(bf16x8, pw);
                const int r0 = 16 * t0 + 4 * g + q4, r1 = 16 * t1 + 4 * g + q4;
#pragma unroll
                for (int dt = 0; dt < 4; ++dt) {
                    const v4i16_t lo = __builtin_amdgcn_ds_read_tr16_b64_v4i16((LAS v4i16_t*)(Vl + r0 * 128 + ((dt ^ ((r0 >> 1) & 3)) << 5) + p4 * 8));
                    const v4i16_t hi = __builtin_amdgcn_ds_read_tr16_b64_v4i16((LAS v4i16_t*)(Vl + r1 * 128 + ((dt ^ ((r1 >> 1) & 3)) << 5) + p4 * 8));
                    const bf16x8 Va = (bf16x8){lo[0], lo[1], lo[2], lo[3], hi[0], hi[1], hi[2], hi[3]};
                    O[dt] = mfma16(Va, Pb, O[dt]); } }
            const float inv = 1.0f / sum; const int stok = ((128 * n + qrow) << dsh) + r; const size_t grow = (size_t)b * SEQ + stok;
            bf16* op = F.ATT + grow * AW + h * 64 + 4 * g;
#pragma unroll
            for (int dt = 0; dt < 4; ++dt) { u32x2 o2; o2.x = pk2(O[dt][0] * inv, O[dt][1] * inv); o2.y = pk2(O[dt][2] * inv, O[dt][3] * inv); *(GAS u32x2*)(op + 16 * dt) = o2; }
            if (g == 0) F.LSE[grow * 12 + h] = mx + logf(sum);
        }
        __syncthreads();
    }
}

__device__ __forceinline__ void p3_alpha(Frame& F) {
    const int gw = F.vcu * NWAVES + F.wave, NGW = F.G * NWAVES, lane = F.lane;
    for (int t = gw; t < T; t += NGW) {
        const float* ls = F.LSE + (size_t)t * 12;
        for (int idx = lane; idx < 96; idx += 64) { const int head = idx >> 3, hg = head & 3, gi = head >> 2;
            const float la = ls[hg], lb = ls[4 + hg], lc = ls[8 + hg]; const float m = fmaxf(la, fmaxf(lb, lc));
            const float ea = __expf(la - m), eb = __expf(lb - m), ec = __expf(lc - m); const float al = ((gi == 0) ? ea : (gi == 1) ? eb : ec) / (ea + eb + ec);
            GAS v4u* p = (GAS v4u*)(F.ATT + (size_t)t * AW + idx * 8); const v4u raw = *p; v4u o;
            o.x = pk2(bf_lo(raw.x) * al, bf_hi(raw.x) * al); o.y = pk2(bf_lo(raw.y) * al, bf_hi(raw.y) * al); o.z = pk2(bf_lo(raw.z) * al, bf_hi(raw.z) * al); o.w = pk2(bf_lo(raw.w) * al, bf_hi(raw.w) * al);
            *p = o; }
    }
}
__device__ __forceinline__ void p3_sgu(Frame& F) {
    LAS float* st = (LAS float*)F.lds; LAS unsigned char* vt0 = F.lds + 1024;
    const int tid = F.tid, lane = F.lane, w = F.wave, c16 = lane & 15, g4 = lane >> 4;
    for (int chunk = F.vcu; chunk < T / 128; chunk += F.G) {
        const int t0 = chunk * 128;
        for (int tt = 0; tt < 16; ++tt) { const int tok = t0 + 16 * w + tt; const bf16* vr = F.Z + (size_t)tok * 1536 + 768;
            float v[12]; float s = 0.f;
#pragma unroll
            for (int it = 0; it < 3; ++it) { const u32x2 raw = *(const GAS u32x2*)(vr + it * 256 + lane * 4); v[4 * it] = bf_lo(raw.x); v[4 * it + 1] = bf_hi(raw.x); v[4 * it + 2] = bf_lo(raw.y); v[4 * it + 3] = bf_hi(raw.y); }
#pragma unroll
            for (int j = 0; j < 12; ++j) s += v[j];
            const float mean = wave_sum(s) * (1.f / 768.f); float q = 0.f;
#pragma unroll
            for (int j = 0; j < 12; ++j) { const float d = v[j] - mean; q += d * d; }
            const float rstd = 1.0f / sqrtf(wave_sum(q) * (1.f / 768.f) + EPS);
            if (lane == 0) { st[(16 * w + tt) * 2] = mean; st[(16 * w + tt) * 2 + 1] = rstd; } }
        __syncthreads();
        for (int gg = 0; gg < 12; ++gg) {
            LAS unsigned char* buf = vt0 + (gg & 1) * 17408;
            { const int s = tid >> 2, q = tid & 3; const bf16* src = F.Z + (size_t)(t0 + s) * 1536 + 768 + gg * 64 + q * 16;
                const v4u r0 = *(const GAS v4u*)src, r1 = *(const GAS v4u*)(src + 8);
                const float mean = st[2 * s], rstd = st[2 * s + 1]; const float* lg = F.sgu_ln_g + gg * 64 + q * 16; const float* lb = F.sgu_ln_b + gg * 64 + q * 16;
                const float v[16] = {bf_lo(r0.x), bf_hi(r0.x), bf_lo(r0.y), bf_hi(r0.y), bf_lo(r0.z), bf_hi(r0.z), bf_lo(r0.w), bf_hi(r0.w), bf_lo(r1.x), bf_hi(r1.x), bf_lo(r1.y), bf_hi(r1.y), bf_lo(r1.z), bf_hi(r1.z), bf_lo(r1.w), bf_hi(r1.w)};
#pragma unroll
                for (int jj = 0; jj < 16; ++jj) { const float val = (v[jj] - mean) * rstd * lg[jj] + lb[jj]; *(LAS unsigned short*)(buf + (q * 16 + jj) * 272 + s * 2) = (unsigned short)f2bf(val); } }
            __syncthreads();
            f32x4 acc[4];
#pragma unroll
            for (int mt = 0; mt < 4; ++mt) acc[mt] = (f32x4){0.f, 0.f, 0.f, 0.f};
            for (int ks = 0; ks <= (w >> 1); ++ks) {
                const bf16x8 Bw = *(const GAS bf16x8*)(F.WSP + (size_t)(gg * 128 + 16 * w + c16) * 128 + 32 * ks + 8 * g4);
#pragma unroll
                for (int mt = 0; mt < 4; ++mt) { const bf16x8 Av = *(const LAS bf16x8*)(buf + (16 * mt + c16) * 272 + (32 * ks + 8 * g4) * 2); acc[mt] = mfma16(Av, Bw, acc[mt]); } }
            const int tok = t0 + 16 * w + c16; const float bias = F.b_spatial[gg * 128 + 16 * w + c16];
            const bf16* up = F.Z + (size_t)tok * 1536 + gg * 64 + 4 * g4; bf16* op = F.SGU + (size_t)tok * AW + gg * 64 + 4 * g4;
#pragma unroll
            for (int mt = 0; mt < 4; ++mt) { const u32x2 u = *(const GAS u32x2*)(up + 16 * mt); u32x2 o2;
                o2.x = pk2(bf_lo(u.x) * (acc[mt][0] + bias), bf_hi(u.x) * (acc[mt][1] + bias)); o2.y = pk2(bf_lo(u.y) * (acc[mt][2] + bias), bf_hi(u.y) * (acc[mt][3] + bias));
                *(GAS u32x2*)(op + 16 * mt) = o2; }
        }
        __syncthreads();
    }
}

__device__ __forceinline__ void p6_router(Frame& F) {
    volatile LAS int* hist = (volatile LAS int*)(F.lds + MOE_OFF + 512); volatile LAS int* wbase = hist + 32;
    const int tid = F.tid, lane = F.lane, w = F.wave, c16 = lane & 15, g = lane >> 4;
    for (int chunk = F.vcu; chunk < T / 128; chunk += F.G) {
        if (tid < 32) hist[tid] = 0;
        __syncthreads();
        const int tok = chunk * 128 + w * 16 + c16; const float* xr = F.out + (size_t)tok * DM;
        f32x4 acc[2]; acc[0] = (f32x4){0.f, 0.f, 0.f, 0.f}; acc[1] = (f32x4){0.f, 0.f, 0.f, 0.f}; float ss = 0.f;
#pragma unroll 4
        for (int ks = 0; ks < 32; ++ks) { const int k0 = 32 * ks + 8 * g;
            const f32x4 a = *(const GAS f32x4*)(xr + k0), b = *(const GAS f32x4*)(xr + k0 + 4);
            const float xv[8] = {a.x, a.y, a.z, a.w, b.x, b.y, b.z, b.w}; unsigned hh[8], ll[8];
#pragma unroll
            for (int j = 0; j < 8; ++j) { ss += xv[j] * xv[j]; hh[j] = f2bf(xv[j]); ll[j] = f2bf(xv[j] - __uint_as_float(hh[j] << 16)); }
            v4u ph, pl; ph.x = hh[0] | (hh[1] << 16); ph.y = hh[2] | (hh[3] << 16); ph.z = hh[4] | (hh[5] << 16); ph.w = hh[6] | (hh[7] << 16);
            pl.x = ll[0] | (ll[1] << 16); pl.y = ll[2] | (ll[3] << 16); pl.z = ll[4] | (ll[5] << 16); pl.w = ll[6] | (ll[7] << 16);
            const bf16x8 xh = __builtin_bit_cast(bf16x8, ph), xl = __builtin_bit_cast(bf16x8, pl);
#pragma unroll
            for (int mt = 0; mt < 2; ++mt) { const bf16x8 wh = *(const GAS bf16x8*)(F.WRH + (size_t)(16 * mt + c16) * 1024 + k0), wl = *(const GAS bf16x8*)(F.WRL + (size_t)(16 * mt + c16) * 1024 + k0);
                acc[mt] = mfma16(wh, xh, acc[mt]); acc[mt] = mfma16(wh, xl, acc[mt]); acc[mt] = mfma16(wl, xh, acc[mt]); } }
        ss += __shfl_xor(ss, 16); ss += __shfl_xor(ss, 32);
        const float rstd = 1.0f / sqrtf(ss * (1.f / DM) + EPS);
        float lg[8];
#pragma unroll
        for (int mt = 0; mt < 2; ++mt)
#pragma unroll
            for (int rg = 0; rg < 4; ++rg) lg[mt * 4 + rg] = acc[mt][rg] * rstd + F.b_router[16 * mt + 4 * g + rg];
        float tv[4]; int te[4];
#pragma unroll
        for (int k = 0; k < 4; ++k) {
            float bv = -3.0e38f; int bi = 0;
#pragma unroll
            for (int s = 0; s < 8; ++s) { const int e = 16 * (s >> 2) + 4 * g + (s & 3); if (lg[s] > bv) { bv = lg[s]; bi = e; } }
#pragma unroll
            for (int o = 16; o < 64; o <<= 1) { const float ov = __shfl_xor(bv, o); const int oi = __shfl_xor(bi, o); if (ov > bv || (ov == bv && oi < bi)) { bv = ov; bi = oi; } }
            tv[k] = bv; te[k] = bi;
#pragma unroll
            for (int s = 0; s < 8; ++s) { const int e = 16 * (s >> 2) + 4 * g + (s & 3); if (e == bi) lg[s] = -3.0e38f; }
        }
        const float e1 = __expf(tv[1] - tv[0]), e2 = __expf(tv[2] - tv[0]), e3 = __expf(tv[3] - tv[0]); const float den = 1.0f / (1.0f + e1 + e2 + e3);
        const float gk = ((g == 0) ? 1.0f : (g == 1) ? e1 : (g == 2) ? e2 : e3) * den; const int ek = (g == 0) ? te[0] : (g == 1) ? te[1] : (g == 2) ? te[2] : te[3];
        const int lpos = atomicAdd((int*)&hist[ek], 1);
        __syncthreads();
        if (tid < 32) { const int cnt = hist[tid]; wbase[tid] = cnt ? (int)__hip_atomic_fetch_add(F.ctl + CW_CNT + 64 * tid, (unsigned)cnt, RLX_AGENT) : 0; }
        __syncthreads();
        const int pos = wbase[ek] + lpos; const size_t li = (size_t)ek * T + pos;
        F.LIST[li] = tok; F.GWL[li] = gk; F.RS[li] = rstd; F.TE[tok * 4 + g] = ek; F.TP[tok * 4 + g] = pos;
        __syncthreads();
    }
}
__device__ __forceinline__ void moe_tables(Frame& F) {
    volatile LAS int* mpt = (volatile LAS int*)(F.lds + MOE_OFF); volatile LAS int* mcnt = mpt + 64;
    if (F.tid == 0) { int a = 0; for (int e = 0; e < 32; ++e) { const int c = (int)__hip_atomic_load(F.ctl + CW_CNT + 64 * e, RLX_AGENT); mcnt[e] = c; mpt[e] = a; a += (c + 255) >> 8; } mpt[32] = a; }
    __syncthreads();
}
__device__ __forceinline__ void p9_combine(Frame& F) {
    volatile LAS int* mpt = (volatile LAS int*)(F.lds + MOE_OFF);
    const int gw = F.vcu * NWAVES + F.wave, NGW = F.G * NWAVES, lane = F.lane;
    for (int t = gw; t < T; t += NGW) {
        size_t srow[4];
#pragma unroll
        for (int k = 0; k < 4; ++k) { const int e = F.TE[t * 4 + k], p = F.TP[t * 4 + k]; srow[k] = ((size_t)mpt[e] * 256 + p) * 1024; }
        GAS f32x4* o = (GAS f32x4*)(F.out + (size_t)t * DM) + lane;
#pragma unroll
        for (int it = 0; it < 4; ++it) { f32x4 v = o[64 * it];
#pragma unroll
            for (int k = 0; k < 4; ++k) { const u32x2 y = *(const GAS u32x2*)(F.Y + srow[k] + it * 256 + lane * 4); v.x += bf_lo(y.x); v.y += bf_hi(y.x); v.z += bf_lo(y.y); v.w += bf_hi(y.y); }
            o[64 * it] = v; }
    }
}

struct Args { const void* in[20]; float* out; unsigned char* ws; int ph_lo, ph_hi; };
__global__ void __launch_bounds__(NWAVES * 64, 2) hybrid_fwd(Args args) {
    extern __shared__ __attribute__((aligned(16))) unsigned char lds[];
    Frame F;
    F.lds = (LAS unsigned char*)lds;
    F.MISC = (volatile LAS unsigned*)(F.lds + MISC_OFF);
    F.tid = threadIdx.x; F.lane = F.tid & 63; F.wave = __builtin_amdgcn_readfirstlane(F.tid >> 6);
    F.G = gridDim.x; { const int bx = blockIdx.x; F.vcu = (F.G % 8 == 0) ? (bx % 8) * (F.G / 8) + bx / 8 : bx; }
    unsigned char* ws = args.ws;
    F.ctl = (gu32*)(ws + WS_CTL);
    F.x = (const float*)args.in[0]; F.positions = (const int*)args.in[1]; F.norm1_g = (const float*)args.in[2]; F.w_in = (const float*)args.in[3];
    F.q_norm_g = (const float*)args.in[4]; F.k_norm_g = (const float*)args.in[5]; F.sgu_ln_g = (const float*)args.in[6]; F.sgu_ln_b = (const float*)args.in[7];
    F.w_spatial = (const float*)args.in[8]; F.b_spatial = (const float*)args.in[9]; F.w_branch_a = (const float*)args.in[10]; F.w_branch_b = (const float*)args.in[11];
    F.w_out = (const float*)args.in[12]; F.norm2_g = (const float*)args.in[13]; F.w_router = (const float*)args.in[14]; F.b_router = (const float*)args.in[15];
    F.w_gate_up = (const float*)args.in[16]; F.b_gate_up = (const float*)args.in[17]; F.w_down = (const float*)args.in[18]; F.b_down = (const float*)args.in[19];
    F.out = args.out;
    F.WIN = (bf16*)(ws + WS_WIN); F.WA = (bf16*)(ws + WS_WA); F.WB = (bf16*)(ws + WS_WB); F.WOUT = (bf16*)(ws + WS_WOUT); F.WSP = (bf16*)(ws + WS_WSP);
    F.WRH = (bf16*)(ws + WS_WRH); F.WRL = (bf16*)(ws + WS_WRL); F.WGU = (bf16*)(ws + WS_WGU); F.WD = (bf16*)(ws + WS_WD); F.XN = (bf16*)(ws + WS_XN);
    F.QKV = (bf16*)(ws + WS_QKV); F.Z = (bf16*)(ws + WS_Z); F.GT = (bf16*)(ws + WS_GT); F.ATT = (bf16*)(ws + WS_ATT); F.SGU = (bf16*)(ws + WS_SGU);
    F.ACT = (bf16*)(ws + WS_ACT); F.Y = (bf16*)(ws + WS_Y);
    F.ROPE = (float*)(ws + WS_ROPE); F.LSE = (float*)(ws + WS_LSE); F.GWL = (float*)(ws + WS_GWL); F.RS = (float*)(ws + WS_RS);
    F.TE = (int*)(ws + WS_TE); F.TP = (int*)(ws + WS_TP); F.LIST = (int*)(ws + WS_LIST);
    for (int u = F.tid; u < (LDS_BYTES - LDSCTL_OFF) / 4; u += NWAVES * 64) ((LAS unsigned*)(F.lds + LDSCTL_OFF))[u] = 0u;
    __syncthreads();
    XcdBarrier bar; bar.bar = (unsigned*)(F.ctl + CW_BAR); bar.x = 0; bar.st = nullptr;
    if (!MK_PER_PHASE) bar = xcd_barrier_post((unsigned*)(F.ctl + CW_BAR), F.MISC + 8);
    const int lo = args.ph_lo, hi = args.ph_hi;
#define IN(k) (lo <= (k) && (k) < hi)
#define SEAM(k) do { if (!MK_PER_PHASE && IN(k) && IN((k) + 1)) xcd_barrier(bar); } while (0)
    bf16* const M1 = F.XN; bf16* const MERGED = F.Z; bf16* const XB = F.XN;
    PG8_LAS unsigned* toktab = (PG8_LAS unsigned*)(F.lds + TOKTAB_OFF);
    volatile PG8_LAS int* mpt = (volatile PG8_LAS int*)(F.lds + MOE_OFF); volatile PG8_LAS int* mcnt = mpt + 64;

    if (IN(0)) { p0_prologue(F); SEAM(0); }
    if (IN(1)) {
        pg8::Gemm g{F.XN, F.WIN, T, INW, DM}; pg8::StaticOrder S; S.init(T, INW, F.G, (int)blockIdx.x);
        pg8::EpiProj E{F.QKV, F.Z, F.GT};
        pg8::gemm_phase<pg8::EpiProj, pg8::StaticOrder, PG8_ALIGN, PG8_SP2>(F.lds + RING_OFF, g, S, E);
        SEAM(1);
    }
    if (IN(2)) { p1b_qknorm(F); SEAM(2); }
    if (IN(3)) { p2_attention(F); SEAM(3); }
    if (IN(4)) { p3_alpha(F); p3_sgu(F); SEAM(4); }
    if (IN(5)) {
        pg8::StaticOrder S; S.init(T, DM, F.G, (int)blockIdx.x);
        { pg8::Gemm g{F.ATT, F.WA, T, DM, AW}; pg8::EpiGate<false> E{F.GT, 0, nullptr, M1};
          pg8::gemm_phase<pg8::EpiGate<false>, pg8::StaticOrder, PG8_ALIGN, PG8_SP2>(F.lds + RING_OFF, g, S, E); }
        VM_WAIT(); __builtin_amdgcn_fence(__ATOMIC_SEQ_CST, "agent"); VM_WAIT(); __syncthreads();
        { pg8::Gemm g{F.SGU, F.WB, T, DM, AW}; pg8::EpiGate<true> E{F.GT, 1024, M1, MERGED};
          pg8::gemm_phase<pg8::EpiGate<true>, pg8::StaticOrder, PG8_ALIGN, PG8_SP2>(F.lds + RING_OFF, g, S, E); }
        SEAM(5);
    }
    if (IN(6)) {
        pg8::Gemm g{MERGED, F.WOUT, T, DM, DM}; pg8::StaticOrder S; S.init(T, DM, F.G, (int)blockIdx.x);
        pg8::EpiResid E{F.x, F.out, XB};
        pg8::gemm_phase<pg8::EpiResid, pg8::StaticOrder, PG8_ALIGN, PG8_SP2>(F.lds + RING_OFF, g, S, E);
        SEAM(6);
    }
    if (IN(7)) { p6_router(F); SEAM(7); }
    if (IN(8)) {
        moe_tables(F);
        pg8::Gemm g{XB, F.WGU, 0, 0, DM}; pg8::MoeOrder S; S.init(mpt, mcnt, 8, F.G, (int)blockIdx.x, T);
        pg8::EpiSwiglu E{F.RS, F.b_gate_up, F.ACT};
        pg8::gemm_phase<pg8::EpiSwiglu, pg8::MoeOrder, PG8_ALIGN, true, true>(F.lds + RING_OFF, g, S, E, toktab, F.LIST);
        SEAM(8);
    }
    if (IN(9)) {
        moe_tables(F);
        pg8::Gemm g{F.ACT, F.WD, 0, 0, DM}; pg8::MoeOrder S; S.init(mpt, mcnt, 4, F.G, (int)blockIdx.x, T);
        pg8::EpiDown E{F.GWL, F.b_down, F.Y};
        pg8::gemm_phase<pg8::EpiDown, pg8::MoeOrder, PG8_ALIGN, PG8_SP2>(F.lds + RING_OFF, g, S, E);
        SEAM(9);
    }
    if (IN(10)) { moe_tables(F); p9_combine(F); }
#undef IN
#undef SEAM
}

extern "C" void kernel_launch(void* const* d_in, const int* in_sizes, int n_in, void* d_out, int out_size, void* d_ws, size_t ws_size, hipStream_t stream) {
    static int grid = 0;
    if (grid == 0) {
        if (n_in != 20 || out_size != T * DM || ws_size < WS_END) { fprintf(stderr, "kernel_launch: unexpected shapes (n_in %d, out %d, ws %zu)\n", n_in, out_size, ws_size); grid = -1; return; }
        int dev = 0, cus = 0;
        if (hipGetDevice(&dev) != hipSuccess || hipDeviceGetAttribute(&cus, hipDeviceAttributeMultiprocessorCount, dev) != hipSuccess) { grid = -1; return; }
        if (hipFuncSetAttribute((const void*)hybrid_fwd, hipFuncAttributeMaxDynamicSharedMemorySize, LDS_BYTES) != hipSuccess) { fprintf(stderr, "kernel_launch: hipFuncSetAttribute failed\n"); grid = -1; return; }
        int per_cu = 0;
        if (hipOccupancyMaxActiveBlocksPerMultiprocessor(&per_cu, (const void*)hybrid_fwd, NWAVES * 64, LDS_BYTES) != hipSuccess || per_cu < 1) fprintf(stderr, "kernel_launch: occupancy query reports %d\n", per_cu);
        (void)hipGetLastError();
        grid = cus;
    }
    if (grid < 0) return;
    if (hipMemsetAsync((char*)d_ws + WS_CTL, 0, CTL_ZERO_BYTES, stream) != hipSuccess) return;
    Args a{};
    for (int i = 0; i < 20; ++i) a.in[i] = d_in[i];
    a.out = (float*)d_out; a.ws = (unsigned char*)d_ws;
#if MK_PER_PHASE
    for (int p = 0; p < N_PHASES; ++p) { a.ph_lo = p; a.ph_hi = p + 1; hipLaunchKernelGGL(hybrid_fwd, dim3(grid), dim3(NWAVES * 64), LDS_BYTES, stream, a); }
#else
    a.ph_lo = 0; a.ph_hi = N_PHASES;
    hipLaunchKernelGGL(hybrid_fwd, dim3(grid), dim3(NWAVES * 64), LDS_BYTES, stream, a);
#endif
}
```

```cpp
#include <hip/hip_runtime.h>
#include <cstdio>
#include <cstdint>
namespace pg8 {
#define PG8_LAS __attribute__((address_space(3)))
typedef unsigned short bf16_t;
typedef short bf16x8 __attribute__((ext_vector_type(8)));
typedef float f32x4 __attribute__((ext_vector_type(4)));
typedef unsigned u32x4 __attribute__((ext_vector_type(4)));
constexpr int BM = 256, BK = 64, HALF = 128, HTB = HALF * BK * 2  , STAGE_BYTES = 8 * HTB, NXCD = 8, WGM = 8;

__host__ __device__ __forceinline__ int lds_byte(int r, int c) { const int st = (r >> 4) * 2 + (c >> 5), rr = r & 15, cc = c & 31, ob = rr * 64 + cc * 2; return st * 1024 + (ob ^ (((ob >> 9) & 1) << 5)); }
__host__ __device__ __forceinline__ void stage_rc(int b, int& R, int& C) { const int st = b / 1024, sb = b % 1024, swz = sb ^ (((sb >> 9) & 1) << 5); R = (st >> 1) * 16 + swz / 64; C = (st & 1) * 32 + (swz % 64) / 2; }
__host__ __device__ __forceinline__ int perm32(int rho) { const int n = rho >> 4, i = rho & 15; return 8 * (i >> 2) + 4 * n + (i & 3); }

struct Unit { int pm, pn, gl, gn, e, ob; };
struct Gemm { const bf16_t* A; const bf16_t* Bt; int M, N, K; };

struct StaticOrder {
    int nM, nN, nwg, G, c;
    __host__ __device__ void init(int M, int N, int G_, int c_) { nM = M / BM; nN = N / BM; nwg = nM * nN; G = G_; c = c_; }
    __host__ __device__ bool next(int i, Unit& u) const {
        const long L = (long)i * G + c; if (L >= nwg) return false;
        int wgid = (int)L; { const int q = nwg / NXCD, r = nwg % NXCD, xcd = wgid % NXCD, off = wgid / NXCD; wgid = (xcd < r ? xcd * (q + 1) : r * (q + 1) + (xcd - r) * q) + off; }
        const int nig = WGM * nN, gid = wgid / nig, fm = gid * WGM, gsz = (nM - fm) < WGM ? (nM - fm) : WGM;
        u.pm = fm + ((wgid % nig) % gsz); u.pn = (wgid % nig) / gsz; u.gl = 0; u.gn = 0; u.e = 0; u.ob = 0; return true;
    }
    __device__ __forceinline__ void a_ready(const Unit&) const {}
    __device__ __forceinline__ void done(const Unit&) const {}
};

__device__ __forceinline__ unsigned cvt_pk_bf16(float lo, float hi) { unsigned r; asm volatile("v_cvt_pk_bf16_f32 %0, %1, %2" : "=v"(r) : "v"(lo), "v"(hi)); return r; }
typedef float f32x2 __attribute__((ext_vector_type(2)));
__device__ __forceinline__ f32x2 gelu_pk(f32x2 v) {
    const f32x2 av = __builtin_elementwise_abs(v), d = av * 0.2316418882f + 1.0f;
    f32x2 t; t.x = __builtin_amdgcn_rcpf(d.x); t.y = __builtin_amdgcn_rcpf(d.y);
    f32x2 q = t * 0.5307027145f + (-0.7265760135f); q = q * t + 0.7107068705f; q = q * t + (-0.142248368f); q = q * t + 0.127414796f; q = q * t;
    const f32x2 s = (v * v) * (-0.72134752044f);
    f32x2 e; e.x = __builtin_amdgcn_exp2f(s.x); e.y = __builtin_amdgcn_exp2f(s.y);
    const f32x2 m = v * (q * e), r = v - m;
    f32x2 o; o.x = v.x < 0.f ? m.x : r.x; o.y = v.y < 0.f ? m.y : r.y; return o;
}

template <int ACT  > struct EpiBf16 {
    static constexpr bool PERM = true, AFTER_DRAIN = false; static_assert(ACT == 0 || ACT == 1, "EpiBf16: ACT is 0 (none) or 1 (gelu_pk)");
    bf16_t* O; int ldc; const float* bias; int split_cols; size_t split_stride; float scale0;
    __device__ __forceinline__ void operator()(const f32x4 (&acc)[2][2][4][2], const Unit& u, int wr, int wc, int fr, int fq) const {
        const int row0 = u.pm * BM + wr * 64 + fr; int colt = u.pn * BM; bf16_t* base = O;
        float sc = 1.f; if (split_cols) { const int t = colt / split_cols; base += (size_t)t * split_stride; colt -= t * split_cols; if (t == 0) sc = scale0; }
        const int col0 = colt + wc * 32 + 8 * fq, bcol0 = u.pn * BM + wc * 32 + 8 * fq;
        f32x4 bv[2][2];
#pragma unroll
        for (int bj = 0; bj < 2; ++bj)
#pragma unroll
            for (int n = 0; n < 2; ++n) bv[bj][n] = bias ? *(const f32x4*)(bias + bcol0 + bj * HALF + 4 * n) : (f32x4){0.f, 0.f, 0.f, 0.f};
#pragma unroll
        for (int ai = 0; ai < 2; ++ai)
#pragma unroll
            for (int m = 0; m < 4; ++m) { bf16_t* rowp = base + (size_t)(row0 + ai * HALF + m * 16) * ldc + col0;
#pragma unroll
                for (int bj = 0; bj < 2; ++bj) { f32x4 v0 = acc[ai][bj][m][0] + bv[bj][0], v1 = acc[ai][bj][m][1] + bv[bj][1];
                    if (ACT == 1) { f32x2 a = gelu_pk((f32x2){v0[0], v0[1]}), b = gelu_pk((f32x2){v0[2], v0[3]}), c = gelu_pk((f32x2){v1[0], v1[1]}), d = gelu_pk((f32x2){v1[2], v1[3]});
                        v0 = (f32x4){a.x, a.y, b.x, b.y}; v1 = (f32x4){c.x, c.y, d.x, d.y}; }
                    v0 = v0 * sc; v1 = v1 * sc; u32x4 w; w.x = cvt_pk_bf16(v0[0], v0[1]); w.y = cvt_pk_bf16(v0[2], v0[3]); w.z = cvt_pk_bf16(v1[0], v1[1]); w.w = cvt_pk_bf16(v1[2], v1[3]);
                    *(u32x4*)(rowp + bj * HALF) = w; } }
    }
};

struct PanelStats {
    unsigned* xbuf;
    unsigned* cnt;
    unsigned* tmo;
    int ntn; float eps;
    unsigned code;
    __device__ __forceinline__ bool run(const f32x4 (&v)[2][2][4][2], const Unit& u, int wr, int wc, int fr, int fq, PG8_LAS unsigned char* lds, int wid, int lane) const {
        typedef float f32x2v __attribute__((ext_vector_type(2)));
        PG8_LAS f32x2v* P = (PG8_LAS f32x2v*)lds;
        PG8_LAS f32x2v* S = (PG8_LAS f32x2v*)(lds + 8192);
        PG8_LAS unsigned* flag = (PG8_LAS unsigned*)(lds + 8192 + 2048);
#pragma unroll
        for (int ai = 0; ai < 2; ++ai)
#pragma unroll
            for (int m = 0; m < 4; ++m) {
                float s = 0.f;
#pragma unroll
                for (int bj = 0; bj < 2; ++bj)
#pragma unroll
                    for (int n = 0; n < 2; ++n) { const f32x4 x = v[ai][bj][m][n]; s += (x[0] + x[1]) + (x[2] + x[3]); }
                s += __shfl_xor(s, 16); s += __shfl_xor(s, 32);
                const float mw = s * (1.0f / 64.0f); float q = 0.f;
#pragma unroll
                for (int bj = 0; bj < 2; ++bj)
#pragma unroll
                    for (int n = 0; n < 2; ++n) { const f32x4 d = v[ai][bj][m][n] - mw; q += (d[0] * d[0] + d[1] * d[1]) + (d[2] * d[2] + d[3] * d[3]); }
                q += __shfl_xor(q, 16); q += __shfl_xor(q, 32);
                if (fq == 0) P[(ai * HALF + wr * 64 + m * 16 + fr) * 4 + wc] = (f32x2v){mw, q};
            }
        asm volatile("s_waitcnt lgkmcnt(0)" ::: "memory"); __builtin_amdgcn_s_barrier(); asm volatile("" ::: "memory");
#if defined(BROKEN_EXCHANGE_NO_WAIT)
#warning BROKEN CONTROL BUILD: the row-statistics exchange does not wait; results are wrong by design
        if (blockIdx.x >= 64) { const long long t0_ = clock64(); while (clock64() - t0_ < 60000) __builtin_amdgcn_s_sleep(8); }
#endif
        const int row = wid * 32 + (lane & 31);
        if (lane < 32) {
            const f32x2v a = P[row * 4 + 0], b = P[row * 4 + 1], c = P[row * 4 + 2], d = P[row * 4 + 3];
            const float mt = (a.x + b.x + c.x + d.x) * 0.25f;
            const float da = a.x - mt, db = b.x - mt, dc = c.x - mt, dd = d.x - mt;
            const float m2 = (a.y + b.y) + (c.y + d.y) + 64.0f * ((da * da + db * db) + (dc * dc + dd * dd));
            unsigned long long* slot = (unsigned long long*)xbuf + ((size_t)(u.pm * BM + row) * 4 + u.pn);
            __hip_atomic_store(slot, ((unsigned long long)__float_as_uint(m2) << 32) | __float_as_uint(mt), __ATOMIC_RELAXED, __HIP_MEMORY_SCOPE_AGENT);
        }
        asm volatile("s_waitcnt vmcnt(0)" ::: "memory");
        if (lane == 0) __hip_atomic_fetch_add(cnt + 64 * u.pm, 1u, __ATOMIC_RELAXED, __HIP_MEMORY_SCOPE_AGENT);
        if (wid == 0) {
            bool dead = false; const unsigned long long t0 = __builtin_amdgcn_s_memrealtime(); const unsigned want = 8u * (unsigned)ntn;
            for (;;) {
#if defined(BROKEN_EXCHANGE_NO_WAIT)
                break;
#endif
                if ((unsigned)__builtin_amdgcn_readfirstlane(__hip_atomic_load(cnt + 64 * u.pm, __ATOMIC_RELAXED, __HIP_MEMORY_SCOPE_AGENT)) >= want) break;
                if (__builtin_amdgcn_s_memrealtime() - t0 > 2000000ull) {
                    if (lane == 0) { unsigned expect = 0u; __hip_atomic_compare_exchange_strong(tmo + 1, &expect, code | (unsigned)(u.pm & 0xff), __ATOMIC_RELAXED, __ATOMIC_RELAXED, __HIP_MEMORY_SCOPE_AGENT);
                                     __hip_atomic_store(tmo, 1u, __ATOMIC_RELAXED, __HIP_MEMORY_SCOPE_AGENT); }
                    dead = true; break; }
                __builtin_amdgcn_s_sleep(2);
            }
            __builtin_amdgcn_fence(__ATOMIC_ACQUIRE, "agent");
            if (lane == 0) flag[0] = dead ? 1u : 0u;
        }
        asm volatile("s_waitcnt vmcnt(0) lgkmcnt(0)" ::: "memory"); __builtin_amdgcn_s_barrier(); asm volatile("" ::: "memory");
        const bool bad = flag[0] != 0u;
        if (lane < 32) {
            const unsigned long long* slot = (const unsigned long long*)xbuf + (size_t)(u.pm * BM + row) * 4; float mt[4], m2[4]; float ms = 0.f;
#pragma unroll
            for (int t = 0; t < 4; ++t) { if (t < ntn) { const unsigned long long w = __hip_atomic_load(slot + t, __ATOMIC_RELAXED, __HIP_MEMORY_SCOPE_AGENT); mt[t] = __uint_as_float((unsigned)w); m2[t] = __uint_as_float((unsigned)(w >> 32)); } else { mt[t] = 0.f; m2[t] = 0.f; } ms += mt[t]; }
            const float mean = ms / (float)ntn; float q = 0.f;
#pragma unroll
            for (int t = 0; t < 4; ++t) if (t < ntn) { const float dm = mt[t] - mean; q += m2[t] + 256.0f * dm * dm; }
            S[row] = (f32x2v){mean, 1.0f / sqrtf(q / (256.0f * (float)ntn) + eps)};
        }
        asm volatile("s_waitcnt lgkmcnt(0)" ::: "memory"); __builtin_amdgcn_s_barrier(); asm volatile("" ::: "memory");
        return bad;
    }
};
struct EpiLnRes {
    static constexpr bool PERM = false, AFTER_DRAIN = true;
    const float* base; float* out; int ldc; const float* bias; PanelStats st; unsigned poison;
    __device__ __forceinline__ void fused(f32x4 (&acc)[2][2][4][2], const Unit& u, int wr, int wc, int fr, int fq, PG8_LAS unsigned char* lds, int wid, int lane) const {
        typedef float f32x2v __attribute__((ext_vector_type(2)));
        const PG8_LAS f32x2v* S = (const PG8_LAS f32x2v*)(lds + 8192);
        const int col0 = u.pn * BM + wc * 32 + 4 * fq;
#pragma unroll
        for (int bj = 0; bj < 2; ++bj)
#pragma unroll
            for (int n = 0; n < 2; ++n) { const f32x4 bv = bias ? *(const f32x4*)(bias + col0 + bj * HALF + n * 16) : (f32x4){0.f, 0.f, 0.f, 0.f};
#pragma unroll
                for (int ai = 0; ai < 2; ++ai)
#pragma unroll
                    for (int m = 0; m < 4; ++m) acc[ai][bj][m][n] += bv; }
        f32x4 pre[4][2][2];
#pragma unroll
        for (int m = 0; m < 4; ++m) { const size_t off = (size_t)(u.pm * BM + wr * 64 + m * 16 + fr) * ldc + col0;
#pragma unroll
            for (int bj = 0; bj < 2; ++bj)
#pragma unroll
                for (int n = 0; n < 2; ++n) pre[m][bj][n] = *(const f32x4*)(base + off + bj * HALF + n * 16); }
        const bool bad = st.run(acc, u, wr, wc, fr, fq, lds, wid, lane) || poison != 0u;
        const float qnan = __builtin_nanf("");
#pragma unroll
        for (int ai = 0; ai < 2; ++ai)
#pragma unroll
            for (int m = 0; m < 4; ++m) { const int r = ai * HALF + wr * 64 + m * 16 + fr; const f32x2v sr = S[r]; const size_t off = (size_t)(u.pm * BM + r) * ldc + col0;
#pragma unroll
                for (int bj = 0; bj < 2; ++bj)
#pragma unroll
                    for (int n = 0; n < 2; ++n) { const f32x4 bs = ai == 0 ? pre[m][bj][n] : *(const f32x4*)(base + off + bj * HALF + n * 16); f32x4 o = bs + (acc[ai][bj][m][n] - sr.x) * sr.y;
                        if (bad) o = (f32x4){qnan, qnan, qnan, qnan}; *(f32x4*)(out + off + bj * HALF + n * 16) = o; }
                if (m & 1) asm volatile("" ::: "memory"); }
    }
};
struct EpiLnResLn {
    static constexpr bool PERM = false, AFTER_DRAIN = true;
    const float* base; float* out; bf16_t* xn; int ldc; const float* bias; PanelStats st1, st2; unsigned poison;
    __device__ __forceinline__ void fused(f32x4 (&acc)[2][2][4][2], const Unit& u, int wr, int wc, int fr, int fq, PG8_LAS unsigned char* lds, int wid, int lane) const {
        typedef float f32x2v __attribute__((ext_vector_type(2))); typedef unsigned u32x2v __attribute__((ext_vector_type(2)));
        const PG8_LAS f32x2v* S = (const PG8_LAS f32x2v*)(lds + 8192);
        const int col0 = u.pn * BM + wc * 32 + 4 * fq;
#pragma unroll
        for (int bj = 0; bj < 2; ++bj)
#pragma unroll
            for (int n = 0; n < 2; ++n) { const f32x4 bv = bias ? *(const f32x4*)(bias + col0 + bj * HALF + n * 16) : (f32x4){0.f, 0.f, 0.f, 0.f};
#pragma unroll
                for (int ai = 0; ai < 2; ++ai)
#pragma unroll
                    for (int m = 0; m < 4; ++m) acc[ai][bj][m][n] += bv; }
        bool bad = st1.run(acc, u, wr, wc, fr, fq, lds, wid, lane) || poison != 0u;
        const float qnan = __builtin_nanf("");
#pragma unroll
        for (int ai = 0; ai < 2; ++ai)
#pragma unroll
            for (int m = 0; m < 4; ++m) { const int r = ai * HALF + wr * 64 + m * 16 + fr; const f32x2v sr = S[r]; const size_t off = (size_t)(u.pm * BM + r) * ldc + col0;
#pragma unroll
                for (int bj = 0; bj < 2; ++bj)
#pragma unroll
                    for (int n = 0; n < 2; ++n) { const f32x4 bs = *(const f32x4*)(base + off + bj * HALF + n * 16); acc[ai][bj][m][n] = bs + (acc[ai][bj][m][n] - sr.x) * sr.y; }
                asm volatile("" : "+v"(acc[ai][0][m][0]), "+v"(acc[ai][0][m][1]), "+v"(acc[ai][1][m][0]), "+v"(acc[ai][1][m][1]));
                if (m & 1) asm volatile("" ::: "memory"); }
        const bool bad1 = bad;
        bad = st2.run(acc, u, wr, wc, fr, fq, lds, wid, lane) || bad;
#pragma unroll
        for (int ai = 0; ai < 2; ++ai)
#pragma unroll
            for (int m = 0; m < 4; ++m) { const int r = ai * HALF + wr * 64 + m * 16 + fr; const f32x2v sr = S[r]; const size_t off = (size_t)(u.pm * BM + r) * ldc + col0;
#pragma unroll
                for (int bj = 0; bj < 2; ++bj)
#pragma unroll
                    for (int n = 0; n < 2; ++n) { const f32x4 x1 = acc[ai][bj][m][n]; *(f32x4*)(out + off + bj * HALF + n * 16) = bad1 ? (f32x4){qnan, qnan, qnan, qnan} : x1;
                        const f32x4 o = (x1 - sr.x) * sr.y; u32x2v w; w.x = cvt_pk_bf16(o[0], o[1]); w.y = cvt_pk_bf16(o[2], o[3]);
                        if (bad) { w.x = 0x7fc07fc0u; w.y = 0x7fc07fc0u; } *(u32x2v*)(xn + off + bj * HALF + n * 16) = w; }
                asm volatile("" ::: "memory"); }
    }
};

typedef int i32x4 __attribute__((ext_vector_type(4)));
template <bool I8> struct AccSel { typedef f32x4 type; };
template <> struct AccSel<true> { typedef i32x4 type; };
template <class Epi, class Sched, bool ALIGN_EPI = false, bool SP2 = false, bool GATHER = false, bool I8 = false>
__device__ __forceinline__ void gemm_phase(PG8_LAS unsigned char* lds, const Gemm g, const Sched& S, const Epi& E, PG8_LAS unsigned* toktab = nullptr, const int* glist = nullptr, bool probe = false) {
    unsigned long long pacc_ = 0ull, pt0_ = 0ull; (void)pt0_;
    static_assert(!GATHER || SP2, "GATHER needs the SP2 loop (lgkmcnt(0)-only waits)");
    const int tid = threadIdx.x, wid = __builtin_amdgcn_readfirstlane(tid >> 6), lane = tid & 63, wr = wid >> 2, wc = wid & 3, fr = lane & 15, fq = lane >> 4;
    const int K = g.K, nt = K / BK;
    unsigned voffA[2], voffB[2];
#pragma unroll
    for (int i = 0; i < 2; ++i) { int R, C; stage_rc(tid * 16 + i * 8192, R, C); const int Rb = Epi::PERM ? ((R & ~31) + perm32(R & 31)) : R;
        voffA[i] = (unsigned)(R * K + C) * 2u; voffB[i] = (unsigned)(Rb * K + C) * 2u; }
    const size_t kstep = (size_t)(BK * 2);
    const size_t hstep = (size_t)HALF * K * 2;
    const size_t tstep = 2 * hstep;
    const unsigned ldsw = (unsigned)wid * 1024u;
    const int aoff = lds_byte(wr * 64 + fr, fq * 8), boff = lds_byte(wc * 32 + fr, fq * 8);
#define PG8_SA(b, h) (((b) * 2 + (h)) * HTB)
#define PG8_SB(b, h) ((4 + (b) * 2 + (h)) * HTB)
#define PG8_STAGE(bufoff, gbase, voff) do { _Pragma("unroll") for (int _i = 0; _i < 2; ++_i) \
        __builtin_amdgcn_global_load_lds((const unsigned*)((const char*)(gbase) + (voff)[_i]), (PG8_LAS unsigned*)(lds + (bufoff) + ldsw + _i * 8192), 16, 0, 0); } while (0)
#define PG8_STAGEA(bufoff, gbase, h) do { if constexpr (GATHER) { PG8_STAGE(bufoff, gbase, oA[h]); } else { PG8_STAGE(bufoff, (gbase) + (h) * hstep, voffA); } } while (0)
#define PG8_EXTRACT(U, bufsel) do { _Pragma("unroll") for (int h_ = 0; h_ < 2; ++h_) _Pragma("unroll") for (int i_ = 0; i_ < 2; ++i_) { const int row_ = h_ * HALF + rowA[i_]; \
        unsigned tk_ = toktab[(bufsel) * 512 + row_]; if (row_ >= (U).gn) tk_ = 0u; oA[h_][i_] = tk_ * (unsigned)(K * 2) + colA2[i_]; } } while (0)
#define PG8_TOKLOAD(U, bufsel) __builtin_amdgcn_global_load_lds((const unsigned*)(glist + (U).gl + tid), toktab + (bufsel) * 512 + wid * 64, 4, 0, 0)
#define PG8_LDA(dst, b, h) do { _Pragma("unroll") for (int m = 0; m < 4; ++m) _Pragma("unroll") for (int k = 0; k < 2; ++k) dst[m][k] = *(const PG8_LAS bf16x8*)(lds + PG8_SA(b, h) + aoff + m * 2048 + k * 1024); } while (0)
#define PG8_LDB(dst, b, h) do { _Pragma("unroll") for (int n = 0; n < 2; ++n) _Pragma("unroll") for (int k = 0; k < 2; ++k) dst[n][k] = *(const PG8_LAS bf16x8*)(lds + PG8_SB(b, h) + boff + n * 2048 + k * 1024); } while (0)
#define PG8_MMA(ai, bj, At, Bt) do { __builtin_amdgcn_s_setprio(1); _Pragma("unroll") for (int m = 0; m < 4; ++m) _Pragma("unroll") for (int n = 0; n < 2; ++n) _Pragma("unroll") for (int k = 0; k < 2; ++k) { \
        if constexpr (I8) acc[ai][bj][m][n] = __builtin_amdgcn_mfma_i32_16x16x64_i8(__builtin_bit_cast(i32x4, Bt[n][k]), __builtin_bit_cast(i32x4, At[m][k]), acc[ai][bj][m][n], 0, 0, 0); \
        else acc[ai][bj][m][n] = __builtin_amdgcn_mfma_f32_16x16x32_bf16(Bt[n][k], At[m][k], acc[ai][bj][m][n], 0, 0, 0); } __builtin_amdgcn_s_setprio(0); } while (0)
#define PG8_WAIT_V(n) asm volatile("s_waitcnt vmcnt(" #n ")" ::: "memory")
#define PG8_WAIT_L(n) asm volatile("s_waitcnt lgkmcnt(" #n ")" ::: "memory")
#define PG8_BAR __builtin_amdgcn_s_barrier()
#define PG8_SCHED __builtin_amdgcn_sched_barrier(0)
    Unit cur, nxt; int ui = 0;
    if (!S.next(0, cur)) return;
    typedef typename AccSel<I8>::type acc_t;
    acc_t acc[2][2][4][2];
#pragma unroll
    for (int a = 0; a < 2; ++a)
#pragma unroll
        for (int b = 0; b < 2; ++b)
#pragma unroll
            for (int m = 0; m < 4; ++m)
#pragma unroll
                for (int n = 0; n < 2; ++n) acc[a][b][m][n] = (acc_t){0, 0, 0, 0};
    bf16x8 At[4][2], B0[2][2], B1[2][2];
    const char* cA = GATHER ? (const char*)g.A : (const char*)g.A + (size_t)cur.pm * tstep; const char* cB = (const char*)g.Bt + (size_t)cur.pn * tstep;
    S.a_ready(cur);
    unsigned oA[2][2] = {{0u, 0u}, {0u, 0u}}; int rowA[2] = {0, 0}; unsigned colA2[2] = {0u, 0u};
    if constexpr (GATHER) {
#pragma unroll
        for (int i = 0; i < 2; ++i) { int R, C; stage_rc(tid * 16 + i * 8192, R, C); rowA[i] = R; colA2[i] = (unsigned)C * 2u; }
        Unit n1; const bool h1 = S.next(1, n1);
        PG8_TOKLOAD(cur, 0); if (h1) PG8_TOKLOAD(n1, 1);
        PG8_WAIT_V(0); PG8_BAR; asm volatile("" ::: "memory");
        PG8_EXTRACT(cur, 0); PG8_WAIT_L(0);
    }
    if constexpr (SP2) {
        PG8_STAGE(PG8_SB(0, 0), cB, voffB); PG8_STAGE(PG8_SB(0, 1), cB + hstep, voffB); PG8_STAGEA(PG8_SA(0, 0), cA, 0); PG8_STAGEA(PG8_SA(0, 1), cA, 1);
        if (wr == 1) PG8_BAR;
        PG8_WAIT_V(2); PG8_BAR;
        PG8_STAGE(PG8_SB(1, 0), cB + kstep, voffB); PG8_STAGEA(PG8_SA(1, 0), cA + kstep, 0); PG8_STAGE(PG8_SB(1, 1), cB + hstep + kstep, voffB);
        PG8_WAIT_V(6); PG8_BAR;
    } else {
        PG8_STAGE(PG8_SB(0, 0), cB, voffB); PG8_STAGEA(PG8_SA(0, 0), cA, 0); PG8_STAGE(PG8_SB(0, 1), cB + hstep, voffB); PG8_STAGEA(PG8_SA(0, 1), cA, 1);
        if (wr == 1) PG8_BAR;
        PG8_WAIT_V(4); PG8_BAR;
        PG8_STAGE(PG8_SB(1, 0), cB + kstep, voffB); PG8_STAGEA(PG8_SA(1, 0), cA + kstep, 0); PG8_STAGE(PG8_SB(1, 1), cB + hstep + kstep, voffB);
        PG8_WAIT_V(6); PG8_BAR;
    }
    for (;;) {
        const bool has_next = S.next(ui + 1, nxt);
        const char* nA = (has_next && !GATHER) ? (const char*)g.A + (size_t)nxt.pm * tstep : cA; const char* nB = has_next ? (const char*)g.Bt + (size_t)nxt.pn * tstep : cB;
        for (int t = 0; t < nt; t += 2) {
            const bool last = (t == nt - 2);
            const char* a1 = cA + (size_t)(t + 1) * kstep;
            const char* a2 = last ? nA : cA + (size_t)(t + 2) * kstep; const char* b2 = last ? nB : cB + (size_t)(t + 2) * kstep;
            const char* a3 = a2 + kstep; const char* b3 = b2 + kstep;
            if (last && has_next) S.a_ready(nxt);
            if constexpr (SP2) {
            PG8_LDB(B0, 0, 0); PG8_LDB(B1, 0, 1); PG8_SCHED; PG8_LDA(At, 0, 0); PG8_STAGEA(PG8_SA(1, 1), a1, 1);
            if constexpr (GATHER) { if (last && has_next) { PG8_EXTRACT(nxt, (ui + 1) & 1); Unit n2; if (S.next(ui + 2, n2)) PG8_TOKLOAD(n2, ui & 1); } }
            PG8_WAIT_V(8); PG8_WAIT_L(0); PG8_BAR; PG8_MMA(0, 0, At, B0); PG8_MMA(0, 1, At, B1); PG8_BAR; PG8_SCHED;
            PG8_LDA(At, 0, 1); PG8_STAGE(PG8_SB(0, 0), b2, voffB); PG8_STAGE(PG8_SB(0, 1), b2 + hstep, voffB); PG8_STAGEA(PG8_SA(0, 0), a2, 0);
            PG8_WAIT_V(8); PG8_WAIT_L(0); PG8_BAR; PG8_MMA(1, 0, At, B0); PG8_MMA(1, 1, At, B1); PG8_BAR; PG8_SCHED;
            PG8_LDB(B0, 1, 0); PG8_LDB(B1, 1, 1); PG8_SCHED; PG8_LDA(At, 1, 0); PG8_STAGEA(PG8_SA(0, 1), a2, 1);
            PG8_WAIT_V(8); PG8_WAIT_L(0); PG8_BAR; PG8_MMA(0, 0, At, B0); PG8_MMA(0, 1, At, B1); PG8_BAR; PG8_SCHED;
            PG8_LDA(At, 1, 1); PG8_STAGE(PG8_SB(1, 0), b3, voffB); PG8_STAGE(PG8_SB(1, 1), b3 + hstep, voffB); PG8_STAGEA(PG8_SA(1, 0), a3, 0);
            PG8_WAIT_V(8); PG8_WAIT_L(0); PG8_BAR; PG8_MMA(1, 0, At, B0); PG8_MMA(1, 1, At, B1); PG8_BAR; PG8_SCHED;
            } else {
            PG8_LDB(B0, 0, 0); PG8_SCHED; PG8_LDA(At, 0, 0); PG8_STAGEA(PG8_SA(1, 1), a1, 1);
            PG8_WAIT_L(8); PG8_BAR; PG8_WAIT_L(0); PG8_MMA(0, 0, At, B0); PG8_BAR; PG8_SCHED;
            PG8_LDB(B1, 0, 1); PG8_STAGE(PG8_SB(0, 0), b2, voffB);
            PG8_BAR; PG8_WAIT_L(0); PG8_MMA(0, 1, At, B1); PG8_BAR;
            PG8_LDA(At, 0, 1); PG8_STAGEA(PG8_SA(0, 0), a2, 0);
            PG8_BAR; PG8_WAIT_L(0); PG8_MMA(1, 0, At, B0); PG8_BAR; PG8_SCHED;
            PG8_STAGE(PG8_SB(0, 1), b2 + hstep, voffB);
            PG8_WAIT_V(6); PG8_BAR; PG8_MMA(1, 1, At, B1); PG8_BAR;
            PG8_LDB(B0, 1, 0); PG8_SCHED; PG8_LDA(At, 1, 0); PG8_STAGEA(PG8_SA(0, 1), a2, 1);
            PG8_WAIT_L(8); PG8_BAR; PG8_WAIT_L(0); PG8_MMA(0, 0, At, B0); PG8_BAR; PG8_SCHED;
            PG8_LDB(B1, 1, 1); PG8_STAGE(PG8_SB(1, 0), b3, voffB);
            PG8_BAR; PG8_WAIT_L(0); PG8_MMA(0, 1, At, B1); PG8_BAR;
            PG8_LDA(At, 1, 1); PG8_STAGEA(PG8_SA(1, 0), a3, 0);
            PG8_BAR; PG8_WAIT_L(0); PG8_MMA(1, 0, At, B0); PG8_BAR; PG8_SCHED;
            PG8_STAGE(PG8_SB(1, 1), b3 + hstep, voffB);
            PG8_WAIT_V(6); PG8_BAR; PG8_MMA(1, 1, At, B1); PG8_BAR;
            }
        }
#ifdef PG8_PROBE
        pt0_ = __builtin_amdgcn_s_memrealtime();
#endif
        if constexpr (ALIGN_EPI) { if (wr == 0) PG8_BAR; }
        if constexpr (!Epi::AFTER_DRAIN) { E(acc, cur, wr, wc, fr, fq); S.done(cur); }
        if (!has_next) break;
#pragma unroll
        for (int a = 0; a < 2; ++a)
#pragma unroll
            for (int b = 0; b < 2; ++b)
#pragma unroll
                for (int m = 0; m < 4; ++m)
#pragma unroll
                    for (int n = 0; n < 2; ++n) acc[a][b][m][n] = (acc_t){0, 0, 0, 0};
        cur = nxt; cA = nA; cB = nB; ++ui;
        if constexpr (ALIGN_EPI) { if (wr == 1) PG8_BAR; }
#ifdef PG8_PROBE
        pacc_ += __builtin_amdgcn_s_memrealtime() - pt0_;
#endif
    }
    PG8_WAIT_V(0);
    if constexpr (!ALIGN_EPI) { if (wr == 0) PG8_BAR; }
    PG8_BAR;
    if constexpr (Epi::AFTER_DRAIN) { E.fused(acc, cur, wr, wc, fr, fq, lds, wid, lane); S.done(cur); }
#ifdef PG8_PROBE
    if (probe && tid == 0) *(PG8_LAS unsigned*)(lds + 131072 + 256) += (unsigned)pacc_;
#endif
#undef PG8_SA
#undef PG8_SB
#undef PG8_STAGE
#undef PG8_STAGEA
#undef PG8_EXTRACT
#undef PG8_TOKLOAD
#undef PG8_LDA
#undef PG8_LDB
#undef PG8_MMA
#undef PG8_WAIT_V
#undef PG8_WAIT_L
#undef PG8_BAR
#undef PG8_SCHED
}
}
namespace pg8 {
__device__ __forceinline__ float bf2f(unsigned short b) { return __uint_as_float((unsigned)b << 16); }
__device__ __forceinline__ float bflo(unsigned w) { return __uint_as_float(w << 16); }
__device__ __forceinline__ float bfhi(unsigned w) { return __uint_as_float(w & 0xffff0000u); }
__device__ __forceinline__ float sigmoidf_(float x) { return __builtin_amdgcn_rcpf(1.0f + __builtin_amdgcn_exp2f(-1.4426950408889634f * x)); }

struct EpiProj {
    static constexpr bool PERM = true, AFTER_DRAIN = false;
    const float* XS; const float* WSC; bf16_t* QKV; bf16_t* Z; bf16_t* GT;
    __device__ __forceinline__ void operator()(const i32x4 (&acc)[2][2][4][2], const Unit& u, int wr, int wc, int fr, int fq) const {
        const int row0 = u.pm * BM + wr * 64 + fr; const int pn = u.pn;
        bf16_t* base; int ldc, colt, mode;
        if (pn < 9) { base = QKV; ldc = 2304; colt = pn * 256; mode = 0; }
        else if (pn < 15) { base = Z; ldc = 1536; colt = (pn - 9) * 256; mode = 1; }
        else { base = GT; ldc = 2048; colt = (pn - 15) * 256; mode = 2; }
        const int col0 = colt + wc * 32 + 8 * fq;
        const float* ws = WSC + pn * 256 + wc * 32 + 8 * fq;
        f32x4 wv[2][2];
#pragma unroll
        for (int bj = 0; bj < 2; ++bj)
#pragma unroll
            for (int n = 0; n < 2; ++n) wv[bj][n] = *(const f32x4*)(ws + bj * HALF + 4 * n);
#pragma unroll
        for (int ai = 0; ai < 2; ++ai)
#pragma unroll
            for (int m = 0; m < 4; ++m) { const int r = row0 + ai * HALF + m * 16; const float xs = XS[r]; bf16_t* rowp = base + (size_t)r * ldc + col0;
#pragma unroll
                for (int bj = 0; bj < 2; ++bj) { f32x4 v0, v1;
#pragma unroll
                    for (int j = 0; j < 4; ++j) { v0[j] = (float)acc[ai][bj][m][0][j] * (xs * wv[bj][0][j]); v1[j] = (float)acc[ai][bj][m][1][j] * (xs * wv[bj][1][j]); }
                    if (mode == 1) { f32x2 a = gelu_pk((f32x2){v0[0], v0[1]}), b = gelu_pk((f32x2){v0[2], v0[3]}), c = gelu_pk((f32x2){v1[0], v1[1]}), d = gelu_pk((f32x2){v1[2], v1[3]});
                        v0 = (f32x4){a.x, a.y, b.x, b.y}; v1 = (f32x4){c.x, c.y, d.x, d.y}; }
                    else if (mode == 2) {
#pragma unroll
                        for (int j = 0; j < 4; ++j) { v0[j] = sigmoidf_(v0[j]); v1[j] = sigmoidf_(v1[j]); } }
                    u32x4 w; w.x = cvt_pk_bf16(v0[0], v0[1]); w.y = cvt_pk_bf16(v0[2], v0[3]); w.z = cvt_pk_bf16(v1[0], v1[1]); w.w = cvt_pk_bf16(v1[2], v1[3]);
                    *(u32x4*)(rowp + bj * HALF) = w; } }
    }
};

template <bool ADD> struct EpiGate {
    static constexpr bool PERM = true, AFTER_DRAIN = false;
    const bf16_t* SG; int sgoff; const bf16_t* M1in; bf16_t* O;
    __device__ __forceinline__ void operator()(const f32x4 (&acc)[2][2][4][2], const Unit& u, int wr, int wc, int fr, int fq) const {
        const int row0 = u.pm * BM + wr * 64 + fr; const int col0 = u.pn * BM + wc * 32 + 8 * fq;
#pragma unroll
        for (int ai = 0; ai < 2; ++ai)
#pragma unroll
            for (int m = 0; m < 4; ++m) { const size_t r = (size_t)(row0 + ai * HALF + m * 16);
#pragma unroll
                for (int bj = 0; bj < 2; ++bj) { const int c = col0 + bj * HALF;
                    const u32x4 s = *(const u32x4*)(SG + r * 2048 + sgoff + c);
                    f32x4 v0 = acc[ai][bj][m][0], v1 = acc[ai][bj][m][1];
                    v0[0] *= bflo(s.x); v0[1] *= bfhi(s.x); v0[2] *= bflo(s.y); v0[3] *= bfhi(s.y); v1[0] *= bflo(s.z); v1[1] *= bfhi(s.z); v1[2] *= bflo(s.w); v1[3] *= bfhi(s.w);
                    if (ADD) { const u32x4 p = *(const u32x4*)(M1in + r * 1024 + c);
                        v0[0] += bflo(p.x); v0[1] += bfhi(p.x); v0[2] += bflo(p.y); v0[3] += bfhi(p.y); v1[0] += bflo(p.z); v1[1] += bfhi(p.z); v1[2] += bflo(p.w); v1[3] += bfhi(p.w); }
                    u32x4 w; w.x = cvt_pk_bf16(v0[0], v0[1]); w.y = cvt_pk_bf16(v0[2], v0[3]); w.z = cvt_pk_bf16(v1[0], v1[1]); w.w = cvt_pk_bf16(v1[2], v1[3]);
                    *(u32x4*)(O + r * 1024 + c) = w; } }
    }
};

struct EpiResid {
    static constexpr bool PERM = false, AFTER_DRAIN = false;
    const float* X; float* OUT;
    __device__ __forceinline__ void operator()(const f32x4 (&acc)[2][2][4][2], const Unit& u, int wr, int wc, int fr, int fq) const {
        typedef unsigned u32x2v __attribute__((ext_vector_type(2)));
        const int row0 = u.pm * BM + wr * 64 + fr; const int col0 = u.pn * BM + wc * 32 + 4 * fq;
#pragma unroll
        for (int ai = 0; ai < 2; ++ai)
#pragma unroll
            for (int m = 0; m < 4; ++m) { const size_t off = (size_t)(row0 + ai * HALF + m * 16) * 1024 + col0;
#pragma unroll
                for (int bj = 0; bj < 2; ++bj)
#pragma unroll
                    for (int n = 0; n < 2; ++n) { const size_t o = off + bj * HALF + n * 16; const f32x4 r = *(const f32x4*)(X + o) + acc[ai][bj][m][n];
                        *(f32x4*)(OUT + o) = r; } }
    }
};

struct EpiSwiglu {
    static constexpr bool PERM = true, AFTER_DRAIN = false;
    const float* RS; const float* WSC; const float* BGU; bf16_t* ACT;
    __device__ __forceinline__ void operator()(const i32x4 (&acc)[2][2][4][2], const Unit& u, int wr, int wc, int fr, int fq) const {
        const int ct = u.pn & 7; const int cw = wc * 32 + 8 * fq;
        const float* bg = BGU + (size_t)u.e * 2048 + ct * 128 + cw; const float* bu = bg + 1024;
        const f32x4 bg0 = *(const f32x4*)bg, bg1 = *(const f32x4*)(bg + 4), bu0 = *(const f32x4*)bu, bu1 = *(const f32x4*)(bu + 4);
        const float* ws = WSC + (size_t)u.pn * 256 + cw;
        const f32x4 wg0 = *(const f32x4*)ws, wg1 = *(const f32x4*)(ws + 4), wu0 = *(const f32x4*)(ws + 128), wu1 = *(const f32x4*)(ws + 132);
#pragma unroll
        for (int ai = 0; ai < 2; ++ai)
#pragma unroll
            for (int m = 0; m < 4; ++m) { const int rr = ai * HALF + wr * 64 + m * 16 + fr; const float rs = RS[u.gl + rr];
                float o[8];
#pragma unroll
                for (int j = 0; j < 4; ++j) {
                    float g = fminf((float)acc[ai][0][m][0][j] * (rs * wg0[j]) + bg0[j], 7.0f), p = fminf(fmaxf((float)acc[ai][1][m][0][j] * (rs * wu0[j]) + bu0[j], -7.0f), 7.0f); o[j] = (p + 1.0f) * (g * sigmoidf_(1.702f * g));
                    g = fminf((float)acc[ai][0][m][1][j] * (rs * wg1[j]) + bg1[j], 7.0f); p = fminf(fmaxf((float)acc[ai][1][m][1][j] * (rs * wu1[j]) + bu1[j], -7.0f), 7.0f); o[4 + j] = (p + 1.0f) * (g * sigmoidf_(1.702f * g)); }
                u32x4 w; w.x = cvt_pk_bf16(o[0], o[1]); w.y = cvt_pk_bf16(o[2], o[3]); w.z = cvt_pk_bf16(o[4], o[5]); w.w = cvt_pk_bf16(o[6], o[7]);
                *(u32x4*)(ACT + (size_t)(u.ob + rr) * 1024 + ct * 128 + cw) = w; }
    }
};

struct EpiDown {
    static constexpr bool PERM = true, AFTER_DRAIN = false;
    const float* GW; const float* BD; bf16_t* Y;
    __device__ __forceinline__ void operator()(const f32x4 (&acc)[2][2][4][2], const Unit& u, int wr, int wc, int fr, int fq) const {
        const int ct = u.pn & 3; const int col0 = ct * 256 + wc * 32 + 8 * fq;
        const float* bd = BD + (size_t)u.e * 1024 + col0;
        f32x4 bv[2][2];
#pragma unroll
        for (int bj = 0; bj < 2; ++bj)
#pragma unroll
            for (int n = 0; n < 2; ++n) bv[bj][n] = *(const f32x4*)(bd + bj * HALF + 4 * n);
#pragma unroll
        for (int ai = 0; ai < 2; ++ai)
#pragma unroll
            for (int m = 0; m < 4; ++m) { const int rr = ai * HALF + wr * 64 + m * 16 + fr; const float gw = GW[u.gl + rr];
#pragma unroll
                for (int bj = 0; bj < 2; ++bj) { const f32x4 v0 = (acc[ai][bj][m][0] + bv[bj][0]) * gw, v1 = (acc[ai][bj][m][1] + bv[bj][1]) * gw;
                    u32x4 w; w.x = cvt_pk_bf16(v0[0], v0[1]); w.y = cvt_pk_bf16(v0[2], v0[3]); w.z = cvt_pk_bf16(v1[0], v1[1]); w.w = cvt_pk_bf16(v1[2], v1[3]);
                    *(u32x4*)(Y + (size_t)(u.ob + rr) * 1024 + col0 + bj * HALF) = w; } }
    }
};

struct MoeOrder {
    volatile PG8_LAS int* mpt; volatile PG8_LAS int* mcnt; int nct, G, c, total, TT;
    __device__ __forceinline__ void init(volatile PG8_LAS int* mpt_, volatile PG8_LAS int* mcnt_, int nct_, int G_, int c_, int TT_) {
        mpt = mpt_; mcnt = mcnt_; nct = nct_; G = G_; c = c_; TT = TT_; total = __builtin_amdgcn_readfirstlane(mpt_[32]) * nct_; }
    __device__ __forceinline__ bool next(int i, Unit& u) const {
        const int L = i * G + c; if (L >= total) return false;
        const int rtg = L / nct, ct = L - rtg * nct; int e = 0;
#pragma unroll 1
        for (int j = 1; j < 32; ++j) { if (__builtin_amdgcn_readfirstlane(mpt[j]) <= rtg) e = j; }
        const int rt = rtg - __builtin_amdgcn_readfirstlane(mpt[e]);
        u.pm = rtg; u.pn = e * nct + ct; u.e = e; u.ob = rtg * 256; u.gl = e * TT + rt * 256; u.gn = __builtin_amdgcn_readfirstlane(mcnt[e]) - rt * 256; return true;
    }
    __device__ __forceinline__ void a_ready(const Unit&) const {}
    __device__ __forceinline__ void done(const Unit&) const {}
};
}
#ifndef PG8_SP2
#define PG8_SP2 true
#endif
#ifndef PG8_ALIGN
#define PG8_ALIGN true
#endif
#ifndef MK_PER_PHASE
#define MK_PER_PHASE 0
#endif
constexpr int NWAVES = 8;
constexpr int BATCH = 16, SEQ = 2048, DM = 1024, T = BATCH * SEQ;
constexpr int NH = 12, AW = 768, INW = 5888, NE = 32;
constexpr float EPS = 1e-6f;
constexpr int N_PHASES = 11;
constexpr size_t MiB = 1u << 20;
constexpr size_t WS_CTL = 0, CTL_ZERO_BYTES = 1 * MiB;
constexpr size_t WS_WIN = 2 * MiB;
constexpr size_t WS_WA = 14 * MiB, WS_WB = 16 * MiB;
constexpr size_t WS_WOUT = 18 * MiB;
constexpr size_t WS_WSP = 20 * MiB;
constexpr size_t WS_WRH = 21 * MiB, WS_WRL = 21 * MiB + 65536;
constexpr size_t WS_WSC = 21 * MiB + 262144;
constexpr size_t WS_WSCIN = 21 * MiB + 524288;
constexpr size_t WS_XS = 31 * MiB;
constexpr size_t WS_ROPE = 22 * MiB;
constexpr size_t WS_TE = 30 * MiB, WS_TP = 30 * MiB + 524288;
constexpr size_t WS_WGU = 32 * MiB;
constexpr size_t WS_WD = 160 * MiB;
constexpr size_t WS_XN = 224 * MiB;
constexpr size_t WS_QKV = 288 * MiB;
constexpr size_t WS_Z = 432 * MiB;
constexpr size_t WS_GT = 528 * MiB;
constexpr size_t WS_ATT = 656 * MiB, WS_SGU = 704 * MiB;
constexpr size_t WS_LSE = 752 * MiB;
constexpr size_t WS_ACT = 288 * MiB;
constexpr size_t WS_Y = 560 * MiB;
constexpr size_t WS_LIST = 832 * MiB, WS_GWL = 837 * MiB, WS_RS = 842 * MiB;
constexpr size_t WS_END = 848 * MiB;
constexpr int CW_TMO = 0, CW_CODE = 1, CW_BAR = 4096, CW_CNT = 8192;
constexpr int RING_OFF = 0, RING_BYTES = 131072;
constexpr int LDSCTL_OFF = RING_BYTES, MISC_OFF = LDSCTL_OFF + 320;
constexpr int TOKTAB_OFF = LDSCTL_OFF + 1024;
constexpr int MOE_OFF = TOKTAB_OFF + 4096;
constexpr int LDS_BYTES = 147456;
static_assert(MOE_OFF + 1024 <= LDS_BYTES, "LDS map");
#define GAS __attribute__((address_space(1)))
#define LAS __attribute__((address_space(3)))
typedef unsigned short bf16;
typedef unsigned v4u __attribute__((ext_vector_type(4)));
typedef float f32x4 __attribute__((ext_vector_type(4)));
typedef short bf16x8 __attribute__((ext_vector_type(8)));
typedef GAS unsigned gu32;
typedef GAS unsigned long long gu64;
#define RLX_AGENT __ATOMIC_RELAXED, __HIP_MEMORY_SCOPE_AGENT
#define LDS_WAIT() asm volatile("s_waitcnt lgkmcnt(0)" ::: "memory")
#define VM_WAIT() asm volatile("s_waitcnt vmcnt(0)" ::: "memory")
__device__ __forceinline__ unsigned long long rt() { return __builtin_amdgcn_s_memrealtime(); }
__device__ __forceinline__ unsigned f2bf(float f) { unsigned u = __builtin_bit_cast(unsigned, f); return (u + 0x7fffu + ((u >> 16) & 1u)) >> 16; }
__device__ __forceinline__ unsigned pk2(float lo, float hi) { return f2bf(lo) | (f2bf(hi) << 16); }

#define XB_TMO      128
#define XB_XCNT(j)  (256  + 64 * (j))
#define XB_XSUB(j)  (1280 + 64 * (j))
#define XB_XGEN(j)  (2304 + 64 * (j))
#define XB_TOP      3328
#define XB_TOPGEN   3392
#define XCD_BAR_WORDS 3456
#define XB_SPIN_CAP (1u << 18)

__device__ __forceinline__ unsigned xb_ld(unsigned* p)              { return __hip_atomic_load(p, __ATOMIC_RELAXED, __HIP_MEMORY_SCOPE_AGENT); }
__device__ __forceinline__ unsigned xb_add(unsigned* p, unsigned v) { return __hip_atomic_fetch_add(p, v, __ATOMIC_RELAXED, __HIP_MEMORY_SCOPE_AGENT); }
__device__ __forceinline__ unsigned xb_xcc_id() { return (unsigned)__builtin_amdgcn_s_getreg((3 << 11) | 20) & 0xFu; }
#define XB_SPIN(cond, bar) do { unsigned _sp = 0; while (cond) { __builtin_amdgcn_s_sleep(1); \
    if ((++_sp & 255u) == 0u) { if (xb_ld(&(bar)[XB_TMO])) break; if (_sp > XB_SPIN_CAP) { atomicAdd(&(bar)[XB_TMO], 1u); break; } } } } while (0)

struct XcdBarrier {
    unsigned* bar; unsigned x;
    volatile LAS unsigned* st;
};

__device__ __forceinline__ XcdBarrier xcd_barrier_post(unsigned* bar, volatile LAS unsigned* st) {
    XcdBarrier b; b.bar = bar; b.x = xb_xcc_id(); b.st = st;
    if (threadIdx.x == 0) (void)xb_add(&bar[XB_XCNT(b.x)], 1u);
    return b;
}
__device__ __forceinline__ void xcd_barrier_complete(unsigned* bar, unsigned x, unsigned& nloc, unsigned& nx) {
    const unsigned G = gridDim.x * gridDim.y * gridDim.z;
    unsigned sum, cnt, mine, sp = 0u;
    for (;;) {
        sum = 0u; cnt = 0u; mine = 0u;
#pragma unroll
        for (unsigned j = 0; j < 16; ++j) { const unsigned c = xb_ld(&bar[XB_XCNT(j)]); sum += c; cnt += (c > 0u) ? 1u : 0u; mine = (j == x) ? c : mine; }
        if (sum == G) break;
        __builtin_amdgcn_s_sleep(1);
        if ((++sp & 255u) == 0u) { if (xb_ld(&bar[XB_TMO])) break; if (sp > XB_SPIN_CAP) { atomicAdd(&bar[XB_TMO], 1u); break; } }
    }
    nloc = mine > 0u ? mine : 1u; nx = cnt > 0u ? cnt : 1u;
}

__device__ __forceinline__ void xcd_barrier(const XcdBarrier& b) {
    asm volatile("s_waitcnt vmcnt(0)" ::: "memory");
    __syncthreads();
    if (threadIdx.x == 0) {
        unsigned* bar = b.bar;
        __builtin_amdgcn_s_waitcnt(0);
        unsigned nloc = b.st[0], nx = b.st[1];
        if (nloc == 0u) { xcd_barrier_complete(bar, b.x, nloc, nx); b.st[0] = nloc; b.st[1] = nx; }
        const unsigned old = xb_add(&bar[XB_XSUB(b.x)], 1u);
        const unsigned gen = old / nloc;
        if (old + 1u == (gen + 1u) * nloc) {
            __builtin_amdgcn_fence(__ATOMIC_RELEASE, "agent");
            asm volatile("s_waitcnt vmcnt(0)" ::: "memory");
            const unsigned og = xb_add(&bar[XB_TOP], 1u);
            const unsigned tg = og / nx;
            if (og + 1u == (tg + 1u) * nx) xb_add(&bar[XB_TOPGEN], 1u);
            else XB_SPIN(xb_ld(&bar[XB_TOPGEN]) == tg, bar);
            __builtin_amdgcn_fence(__ATOMIC_ACQUIRE, "agent");
            xb_add(&bar[XB_XGEN(b.x)], 1u);
            asm volatile("s_waitcnt vmcnt(0)" ::: "memory");
        } else {
            XB_SPIN(xb_ld(&bar[XB_XGEN(b.x)]) == gen, bar);
            __builtin_amdgcn_fence(__ATOMIC_ACQUIRE, "agent");
            asm volatile("s_waitcnt vmcnt(0)" ::: "memory");
        }
    }
    __syncthreads();
}
typedef short v4i16_t __attribute__((ext_vector_type(4)));
typedef unsigned u32x2 __attribute__((ext_vector_type(2)));
struct Frame {
    LAS unsigned char* lds;
    volatile LAS unsigned* MISC;
    gu32* ctl;
    int tid, lane, wave;
    int vcu, G;
    const float* x; const int* positions; const float *norm1_g, *w_in, *q_norm_g, *k_norm_g, *sgu_ln_g, *sgu_ln_b, *w_spatial, *b_spatial, *w_branch_a, *w_branch_b, *w_out, *norm2_g,
        *w_router, *b_router, *w_gate_up, *b_gate_up, *w_down, *b_down;
    float* out;
    bf16 *WIN, *WA, *WB, *WOUT, *WSP, *WRH, *WRL, *WGU, *WD, *XN, *QKV, *Z, *GT, *ATT, *SGU, *ACT, *Y;
    float *ROPE, *LSE, *GWL, *RS, *WSC, *WSCIN, *XS; int *TE, *TP, *LIST; unsigned char* XQ;
};
__device__ __forceinline__ float wave_sum(float v) {
#pragma unroll
    for (int o = 1; o < 64; o <<= 1) v += __shfl_xor(v, o);
    return v;
}
__device__ __forceinline__ float bf_lo(unsigned w) { return __uint_as_float(w << 16); }
__device__ __forceinline__ float bf_hi(unsigned w) { return __uint_as_float(w & 0xffff0000u); }
__device__ __forceinline__ f32x4 mfma16(bf16x8 a, bf16x8 b, f32x4 c) { return __builtin_amdgcn_mfma_f32_16x16x32_bf16(a, b, c, 0, 0, 0); }

template <bool I8>
__device__ __forceinline__ void p0_strip(Frame& F, const float* W, int K, int N, int n0, void* dst, size_t drow, const float* kscale, float* wsc) {
    LAS float* S = (LAS float*)F.lds; LAS float* red = (LAS float*)(F.lds + TOKTAB_OFF);
    const int tid = F.tid, nch = K * 8;
#pragma unroll 8
    for (int idx = tid; idx < nch; idx += NWAVES * 64) { const int k = idx >> 3, c = idx & 7; f32x4 v = *(const GAS f32x4*)(W + (size_t)k * N + n0 + c * 4); if (kscale) v = v * kscale[k]; *(LAS f32x4*)(S + k * 32 + c * 4) = v; }
    __syncthreads();
    const int n = tid & 31, kseg = tid >> 5, nseg = K >> 6; const bool act = kseg < nseg;
    float v[64];
#pragma unroll
    for (int j = 0; j < 64; ++j) v[j] = act ? S[(kseg * 64 + j) * 32 + n] : 0.f;
    if (I8) {
        float am = 0.f;
#pragma unroll
        for (int j = 0; j < 64; ++j) am = fmaxf(am, fabsf(v[j]));
        red[kseg * 32 + n] = am;
        __syncthreads();
        float a = 0.f;
        for (int s = 0; s < nseg; ++s) a = fmaxf(a, red[s * 32 + n]);
        const float inv = a > 0.f ? 127.0f / a : 0.f;
        if (kseg == 0) wsc[drow + n] = a * (1.0f / 127.0f);
        if (act) { GAS v4u* d = (GAS v4u*)((char*)dst + (drow + n) * (size_t)K + kseg * 64);
#pragma unroll
            for (int q = 0; q < 4; ++q) { unsigned w[4];
#pragma unroll
                for (int u = 0; u < 4; ++u) { unsigned x = 0u;
#pragma unroll
                    for (int b = 0; b < 4; ++b) { const int iv = (int)rintf(v[q * 16 + u * 4 + b] * inv); x |= ((unsigned)iv & 0xffu) << (8 * b); }
                    w[u] = x; }
                d[q] = (v4u){w[0], w[1], w[2], w[3]}; } }
    } else {
        if (act) { GAS v4u* d = (GAS v4u*)((bf16*)dst + (drow + n) * (size_t)K + kseg * 64);
#pragma unroll
            for (int q = 0; q < 8; ++q) d[q] = (v4u){pk2(v[q * 8], v[q * 8 + 1]), pk2(v[q * 8 + 2], v[q * 8 + 3]), pk2(v[q * 8 + 4], v[q * 8 + 5]), pk2(v[q * 8 + 6], v[q * 8 + 7])}; }
    }
    __syncthreads();
}
__device__ __forceinline__ void p0_prologue(Frame& F) {
    const int gw = F.vcu * NWAVES + F.wave, NGW = F.G * NWAVES, lane = F.lane;
    constexpr int I_IN = 184, I_A = 32, I_OUT = 32, I_GU = 32 * 64, I_D = 32 * 32;
    constexpr int NITEMS = I_IN + 2 * I_A + I_OUT + I_GU + I_D;
    for (int it = F.vcu; it < NITEMS; it += F.G) {
        int r = it;
        if (r < I_GU) { const int e = r >> 6, n0 = 32 * (r & 63); const int nn = n0 & 1023; const size_t drow = (size_t)e * 2048 + (nn >> 7) * 256 + (n0 >= 1024 ? 128 : 0) + (nn & 127);
            p0_strip<true>(F, F.w_gate_up + (size_t)e * 1024 * 2048, 1024, 2048, n0, F.WGU, drow, F.norm2_g, F.WSC); continue; } r -= I_GU;
        if (r < I_D) { const int e = r >> 5, n0 = 32 * (r & 31); p0_strip<false>(F, F.w_down + (size_t)e * 1024 * 1024, 1024, 1024, n0, F.WD, (size_t)e * 1024 + n0, nullptr, nullptr); continue; } r -= I_D;
        if (r < I_IN) { p0_strip<true>(F, F.w_in, 1024, INW, 32 * r, F.WIN, 32 * r, nullptr, F.WSCIN); continue; } r -= I_IN;
        if (r < I_A) { p0_strip<false>(F, F.w_branch_a, 768, 1024, 32 * r, F.WA, 32 * r, nullptr, nullptr); continue; } r -= I_A;
        if (r < I_A) { p0_strip<false>(F, F.w_branch_b, 768, 1024, 32 * r, F.WB, 32 * r, nullptr, nullptr); continue; } r -= I_A;
        p0_strip<false>(F, F.w_out, 1024, 1024, 32 * r, F.WOUT, 32 * r, nullptr, nullptr);
    }
    for (int m = gw; m < T; m += NGW) {
        const GAS f32x4* xr = (const GAS f32x4*)(F.x + (size_t)m * DM) + lane; const GAS f32x4* gr = (const GAS f32x4*)F.norm1_g + lane;
        f32x4 v[4]; float s = 0.f, am = 0.f;
#pragma unroll
        for (int j = 0; j < 4; ++j) { v[j] = xr[64 * j]; s += (v[j].x * v[j].x + v[j].y * v[j].y) + (v[j].z * v[j].z + v[j].w * v[j].w); v[j] = v[j] * gr[64 * j];
            am = fmaxf(fmaxf(am, fmaxf(fabsf(v[j].x), fabsf(v[j].y))), fmaxf(fabsf(v[j].z), fabsf(v[j].w))); }
        const float rstd = 1.0f / sqrtf(wave_sum(s) * (1.f / DM) + EPS);
#pragma unroll
        for (int o = 1; o < 64; o <<= 1) am = fmaxf(am, __shfl_xor(am, o));
        const float qinv = am > 0.f ? 127.0f / am : 0.f;
        GAS unsigned* o4 = (GAS unsigned*)(F.XQ + (size_t)m * DM) + lane;
#pragma unroll
        for (int j = 0; j < 4; ++j) o4[64 * j] = ((unsigned)(int)rintf(v[j].x * qinv) & 0xffu) | (((unsigned)(int)rintf(v[j].y * qinv) & 0xffu) << 8) | (((unsigned)(int)rintf(v[j].z * qinv) & 0xffu) << 16) | (((unsigned)(int)rintf(v[j].w * qinv) & 0xffu) << 24);
        if (lane == 0) F.XS[m] = rstd * am * (1.0f / 127.0f);
    }
    const int gt = F.vcu * (NWAVES * 64) + F.tid, NGT = F.G * NWAVES * 64;
    for (int i = gt; i < 12 * 128 * 128; i += NGT) { const int s = i & 127, t = (i >> 7) & 127; F.WSP[i] = (bf16)((s <= t) ? f2bf(F.w_spatial[i]) : 0u); }
    for (int i = gt; i < T * 32; i += NGT) { const int t = i >> 5, f = i & 31;
        const float inv = powf(10000.0f, -(float)f * (1.0f / 32.0f)); const float ang = (float)F.positions[t] * inv;
        const double rev = (double)ang * 0.15915494309189535; const float fr = (float)(rev - floor(rev));
        F.ROPE[2 * i] = __builtin_amdgcn_cosf(fr); F.ROPE[2 * i + 1] = __builtin_amdgcn_sinf(fr); }
    for (int i = gt; i < 32 * 1024; i += NGT) { const int e = i >> 10, k = i & 1023; const float v = F.norm2_g[k] * F.w_router[k * 32 + e];
        const unsigned h = f2bf(v); const float hf = __uint_as_float(h << 16); F.WRH[i] = (bf16)h; F.WRL[i] = (bf16)f2bf(v - hf); }
}

__device__ __forceinline__ void p1b_qknorm(Frame& F, bool dry = false) {
    const int gw = F.vcu * NWAVES + F.wave, NGW = F.G * NWAVES, lane = F.lane, c = lane & 7;
    for (int t = gw; t < T; t += NGW) {
        bf16* row = F.QKV + (size_t)t * 2304; const float* tab = F.ROPE + (size_t)t * 64;
#pragma unroll
        for (int it = 0; it < 3; ++it) {
            const int hr = it * 8 + (lane >> 3);
            GAS v4u* p = (GAS v4u*)(row + hr * 64 + c * 8); const v4u raw = *p;
            float v[8] = {bf_lo(raw.x), bf_hi(raw.x), bf_lo(raw.y), bf_hi(raw.y), bf_lo(raw.z), bf_hi(raw.z), bf_lo(raw.w), bf_hi(raw.w)};
            float ss = 0.f;
#pragma unroll
            for (int j = 0; j < 8; ++j) ss += v[j] * v[j];
            ss += __shfl_xor(ss, 1); ss += __shfl_xor(ss, 2); ss += __shfl_xor(ss, 4);
            const float rstd = 1.0f / sqrtf(ss * (1.f / 64.f) + EPS);
            const float* gg = ((hr < 12) ? F.q_norm_g : F.k_norm_g) + c * 8;
            float o[8];
#pragma unroll
            for (int j = 0; j < 8; ++j) v[j] = v[j] * rstd * gg[j];
#pragma unroll
            for (int j = 0; j < 8; ++j) { const float pr = __shfl_xor(v[j], 4); const float cs = tab[2 * ((c & 3) * 8 + j)], sn = tab[2 * ((c & 3) * 8 + j) + 1];
                o[j] = (c < 4) ? (v[j] * cs - pr * sn) : (v[j] * cs + pr * sn); }
            v4u w; w.x = pk2(o[0], o[1]); w.y = pk2(o[2], o[3]); w.z = pk2(o[4], o[5]); w.w = pk2(o[6], o[7]);
            if (dry) *(GAS v4u*)(F.ATT + (size_t)t * 1536 + hr * 64 + c * 8) = w; else *p = w;
        }
    }
}

__device__ __forceinline__ void p2_attention(Frame& F) {
    LAS unsigned char* Ql = F.lds; LAS unsigned char* Kl = F.lds + 16384; LAS unsigned char* Vl = F.lds + 49152;
    const int tid = F.tid, lane = F.lane, w = F.wave, c16 = lane & 15, g = lane >> 4;
    for (int unit = F.vcu; unit < BATCH * NH * 16; unit += F.G) {
        const int b = unit / 192, rem = unit - b * 192, h = rem >> 4, blk = rem & 15;
        const int dsh = 2 * (h >> 2), nbk = 16 >> dsh, r = blk >> (4 - dsh), n = blk & (nbk - 1);
        const bf16* base = F.QKV + (size_t)b * SEQ * 2304 + h * 64;
        v4u qv[2], kv[4], vv[4];
#pragma unroll
        for (int i = 0; i < 2; ++i) { const int idx = tid + i * 512, row = idx >> 3, c = idx & 7; const int s = ((128 * n + row) << dsh) + r; qv[i] = *(const GAS v4u*)(base + (size_t)s * 2304 + c * 8); }
#pragma unroll
        for (int i = 0; i < 4; ++i) { const int idx = tid + i * 512, row = idx >> 3, c = idx & 7; const int mk = 128 * (n - 1) + row;
            if (mk >= 0) { const int s = (mk << dsh) + r; const bf16* p = base + (size_t)s * 2304 + c * 8; kv[i] = *(const GAS v4u*)(p + 768); vv[i] = *(const GAS v4u*)(p + 1536); }
            else { kv[i] = (v4u){0u, 0u, 0u, 0u}; vv[i] = (v4u){0u, 0u, 0u, 0u}; } }
#pragma unroll
        for (int i = 0; i < 2; ++i) { const int idx = tid + i * 512, row = idx >> 3, c = idx & 7; *(LAS v4u*)(Ql + row * 128 + ((c ^ ((row >> 1) & 7)) << 4)) = qv[i]; }
#pragma unroll
        for (int i = 0; i < 4; ++i) { const int idx = tid + i * 512, row = idx >> 3, c = idx & 7;
            *(LAS v4u*)(Kl + row * 128 + ((c ^ ((row >> 1) & 7)) << 4)) = kv[i];
            *(LAS v4u*)(Vl + row * 128 + ((((c >> 1) ^ ((row >> 1) & 3))) << 5) + ((c & 1) << 4)) = vv[i]; }
        __syncthreads();
        {
            const int qrow = 16 * w + c16;
            bf16x8 Qb[2];
#pragma unroll
            for (int ks = 0; ks < 2; ++ks) { const int ch = g + 4 * ks; Qb[ks] = *(const LAS bf16x8*)(Ql + qrow * 128 + ((ch ^ ((qrow >> 1) & 7)) << 4)); }
            f32x4 S[10];
#pragma unroll
            for (int tt = 0; tt < 9; ++tt) { const int krow = 16 * (w + tt) + c16; f32x4 a = (f32x4){0.f, 0.f, 0.f, 0.f};
#pragma unroll
                for (int ks = 0; ks < 2; ++ks) { const int ch = g + 4 * ks; const bf16x8 Ka = *(const LAS bf16x8*)(Kl + krow * 128 + ((ch ^ ((krow >> 1) & 7)) << 4)); a = mfma16(Ka, Qb[ks], a); }
                S[tt] = a; }
            S[9] = (f32x4){0.f, 0.f, 0.f, 0.f};
            float mx = -3.0e38f;
#pragma unroll
            for (int tt = 0; tt < 9; ++tt)
#pragma unroll
                for (int rg = 0; rg < 4; ++rg) { const int j = 16 * (w + tt) + 4 * g + rg, dist = 128 + qrow - j, mk = 128 * (n - 1) + j;
                    const bool valid = (dist >= 0) && (dist <= 128) && (mk >= 0); const float s = valid ? S[tt][rg] * 0.125f : -1.0e30f; S[tt][rg] = s; mx = fmaxf(mx, s); }
            mx = fmaxf(mx, __shfl_xor(mx, 16)); mx = fmaxf(mx, __shfl_xor(mx, 32));
            float sum = 0.f;
#pragma unroll
            for (int tt = 0; tt < 9; ++tt)
#pragma unroll
                for (int rg = 0; rg < 4; ++rg) { const float p = __builtin_amdgcn_exp2f((S[tt][rg] - mx) * 1.4426950408889634f); S[tt][rg] = p; sum += p; }
            sum += __shfl_xor(sum, 16); sum += __shfl_xor(sum, 32);
            f32x4 O[4];
#pragma unroll
            for (int dt = 0; dt < 4; ++dt) O[dt] = (f32x4){0.f, 0.f, 0.f, 0.f};
            const int q4 = (lane >> 2) & 3, p4 = lane & 3;
#pragma unroll
            for (int kp = 0; kp < 5; ++kp) { const int t0 = w + 2 * kp; int t1 = w + 2 * kp + 1; t1 = t1 > 15 ? 15 : t1;
                v4u pw; pw.x = pk2(S[2 * kp][0], S[2 * kp][1]); pw.y = pk2(S[2 * kp][2], S[2 * kp][3]); pw.z = pk2(S[2 * kp + 1][0], S[2 * kp + 1][1]); pw.w = pk2(S[2 * kp + 1][2], S[2 * kp + 1][3]);
                const bf16x8 Pb = __builtin_bit_cast(bf16x8, pw);
                const int r0 = 16 * t0 + 4 * g + q4, r1 = 16 * t1 + 4 * g + q4;
#pragma unroll
                for (int dt = 0; dt < 4; ++dt) {
                    const v4i16_t lo = __builtin_amdgcn_ds_read_tr16_b64_v4i16((LAS v4i16_t*)(Vl + r0 * 128 + ((dt ^ ((r0 >> 1) & 3)) << 5) + p4 * 8));
                    const v4i16_t hi = __builtin_amdgcn_ds_read_tr16_b64_v4i16((LAS v4i16_t*)(Vl + r1 * 128 + ((dt ^ ((r1 >> 1) & 3)) << 5) + p4 * 8));
                    const bf16x8 Va = (bf16x8){lo[0], lo[1], lo[2], lo[3], hi[0], hi[1], hi[2], hi[3]};
                    O[dt] = mfma16(Va, Pb, O[dt]); } }
            const float inv = 1.0f / sum; const int stok = ((128 * n + qrow) << dsh) + r; const size_t grow = (size_t)b * SEQ + stok;
            bf16* op = F.ATT + grow * AW + h * 64 + 4 * g;
#pragma unroll
            for (int dt = 0; dt < 4; ++dt) { u32x2 o2; o2.x = pk2(O[dt][0] * inv, O[dt][1] * inv); o2.y = pk2(O[dt][2] * inv, O[dt][3] * inv); *(GAS u32x2*)(op + 16 * dt) = o2; }
            if (g == 0) F.LSE[grow * 12 + h] = mx + logf(sum);
        }
        __syncthreads();
    }
}

__device__ __forceinline__ void p3_alpha(Frame& F, bool dry = false) {
    const int gw = F.vcu * NWAVES + F.wave, NGW = F.G * NWAVES, lane = F.lane;
    for (int t = gw; t < T; t += NGW) {
        const float* ls = F.LSE + (size_t)t * 12;
        for (int idx = lane; idx < 96; idx += 64) { const int head = idx >> 3, hg = head & 3, gi = head >> 2;
            const float la = ls[hg], lb = ls[4 + hg], lc = ls[8 + hg]; const float m = fmaxf(la, fmaxf(lb, lc));
            const float ea = __expf(la - m), eb = __expf(lb - m), ec = __expf(lc - m); const float al = ((gi == 0) ? ea : (gi == 1) ? eb : ec) / (ea + eb + ec);
            GAS v4u* p = (GAS v4u*)(F.ATT + (size_t)t * AW + idx * 8); const v4u raw = *p; v4u o;
            o.x = pk2(bf_lo(raw.x) * al, bf_hi(raw.x) * al); o.y = pk2(bf_lo(raw.y) * al, bf_hi(raw.y) * al); o.z = pk2(bf_lo(raw.z) * al, bf_hi(raw.z) * al); o.w = pk2(bf_lo(raw.w) * al, bf_hi(raw.w) * al);
            if (dry) *(GAS v4u*)(F.SGU + (size_t)t * AW + idx * 8) = o; else *p = o; }
    }
}
__device__ __forceinline__ void p3_sgu(Frame& F) {
    LAS float* st = (LAS float*)F.lds; LAS unsigned char* vt0 = F.lds + 1024;
    const int tid = F.tid, lane = F.lane, w = F.wave, c16 = lane & 15, g4 = lane >> 4;
    for (int chunk = F.vcu; chunk < T / 128; chunk += F.G) {
        const int t0 = chunk * 128;
        for (int tt = 0; tt < 16; ++tt) { const int tok = t0 + 16 * w + tt; const bf16* vr = F.Z + (size_t)tok * 1536 + 768;
            float v[12]; float s = 0.f;
#pragma unroll
            for (int it = 0; it < 3; ++it) { const u32x2 raw = *(const GAS u32x2*)(vr + it * 256 + lane * 4); v[4 * it] = bf_lo(raw.x); v[4 * it + 1] = bf_hi(raw.x); v[4 * it + 2] = bf_lo(raw.y); v[4 * it + 3] = bf_hi(raw.y); }
#pragma unroll
            for (int j = 0; j < 12; ++j) s += v[j];
            const float mean = wave_sum(s) * (1.f / 768.f); float q = 0.f;
#pragma unroll
            for (int j = 0; j < 12; ++j) { const float d = v[j] - mean; q += d * d; }
            const float rstd = 1.0f / sqrtf(wave_sum(q) * (1.f / 768.f) + EPS);
            if (lane == 0) { st[(16 * w + tt) * 2] = mean; st[(16 * w + tt) * 2 + 1] = rstd; } }
        __syncthreads();
        for (int gg = 0; gg < 12; ++gg) {
            LAS unsigned char* buf = vt0 + (gg & 1) * 17408;
            { const int s = tid >> 2, q = tid & 3; const bf16* src = F.Z + (size_t)(t0 + s) * 1536 + 768 + gg * 64 + q * 16;
                const v4u r0 = *(const GAS v4u*)src, r1 = *(const GAS v4u*)(src + 8);
                const float mean = st[2 * s], rstd = st[2 * s + 1]; const float* lg = F.sgu_ln_g + gg * 64 + q * 16; const float* lb = F.sgu_ln_b + gg * 64 + q * 16;
                const float v[16] = {bf_lo(r0.x), bf_hi(r0.x), bf_lo(r0.y), bf_hi(r0.y), bf_lo(r0.z), bf_hi(r0.z), bf_lo(r0.w), bf_hi(r0.w), bf_lo(r1.x), bf_hi(r1.x), bf_lo(r1.y), bf_hi(r1.y), bf_lo(r1.z), bf_hi(r1.z), bf_lo(r1.w), bf_hi(r1.w)};
#pragma unroll
                for (int jj = 0; jj < 16; ++jj) { const float val = (v[jj] - mean) * rstd * lg[jj] + lb[jj]; *(LAS unsigned short*)(buf + (q * 16 + jj) * 272 + s * 2) = (unsigned short)f2bf(val); } }
            __syncthreads();
            f32x4 acc[4];
#pragma unroll
            for (int mt = 0; mt < 4; ++mt) acc[mt] = (f32x4){0.f, 0.f, 0.f, 0.f};
            for (int ks = 0; ks <= (w >> 1); ++ks) {
                const bf16x8 Bw = *(const GAS bf16x8*)(F.WSP + (size_t)(gg * 128 + 16 * w + c16) * 128 + 32 * ks + 8 * g4);
#pragma unroll
                for (int mt = 0; mt < 4; ++mt) { const bf16x8 Av = *(const LAS bf16x8*)(buf + (16 * mt + c16) * 272 + (32 * ks + 8 * g4) * 2); acc[mt] = mfma16(Av, Bw, acc[mt]); } }
            const int tok = t0 + 16 * w + c16; const float bias = F.b_spatial[gg * 128 + 16 * w + c16];
            const bf16* up = F.Z + (size_t)tok * 1536 + gg * 64 + 4 * g4; bf16* op = F.SGU + (size_t)tok * AW + gg * 64 + 4 * g4;
#pragma unroll
            for (int mt = 0; mt < 4; ++mt) { const u32x2 u = *(const GAS u32x2*)(up + 16 * mt); u32x2 o2;
                o2.x = pk2(bf_lo(u.x) * (acc[mt][0] + bias), bf_hi(u.x) * (acc[mt][1] + bias)); o2.y = pk2(bf_lo(u.y) * (acc[mt][2] + bias), bf_hi(u.y) * (acc[mt][3] + bias));
                *(GAS u32x2*)(op + 16 * mt) = o2; }
        }
        __syncthreads();
    }
}

__device__ __forceinline__ void p6_router(Frame& F) {
    volatile LAS int* hist = (volatile LAS int*)(F.lds + MOE_OFF + 512); volatile LAS int* wbase = hist + 32;
    const int tid = F.tid, lane = F.lane, w = F.wave, c16 = lane & 15, g = lane >> 4;
    for (int chunk = F.vcu; chunk < T / 128; chunk += F.G) {
        if (tid < 32) hist[tid] = 0;
        __syncthreads();
        const int tok = chunk * 128 + w * 16 + c16; const float* xr = F.out + (size_t)tok * DM;
        f32x4 acc[2]; acc[0] = (f32x4){0.f, 0.f, 0.f, 0.f}; acc[1] = (f32x4){0.f, 0.f, 0.f, 0.f}; float ss = 0.f, am = 0.f;
#pragma unroll 4
        for (int ks = 0; ks < 32; ++ks) { const int k0 = 32 * ks + 8 * g;
            const f32x4 a = *(const GAS f32x4*)(xr + k0), b = *(const GAS f32x4*)(xr + k0 + 4);
            const float xv[8] = {a.x, a.y, a.z, a.w, b.x, b.y, b.z, b.w}; unsigned hh[8], ll[8];
#pragma unroll
            for (int j = 0; j < 8; ++j) { ss += xv[j] * xv[j]; am = fmaxf(am, fabsf(xv[j])); hh[j] = f2bf(xv[j]); ll[j] = f2bf(xv[j] - __uint_as_float(hh[j] << 16)); }
            v4u ph, pl; ph.x = hh[0] | (hh[1] << 16); ph.y = hh[2] | (hh[3] << 16); ph.z = hh[4] | (hh[5] << 16); ph.w = hh[6] | (hh[7] << 16);
            pl.x = ll[0] | (ll[1] << 16); pl.y = ll[2] | (ll[3] << 16); pl.z = ll[4] | (ll[5] << 16); pl.w = ll[6] | (ll[7] << 16);
            const bf16x8 xh = __builtin_bit_cast(bf16x8, ph), xl = __builtin_bit_cast(bf16x8, pl);
#pragma unroll
            for (int mt = 0; mt < 2; ++mt) { const bf16x8 wh = *(const GAS bf16x8*)(F.WRH + (size_t)(16 * mt + c16) * 1024 + k0), wl = *(const GAS bf16x8*)(F.WRL + (size_t)(16 * mt + c16) * 1024 + k0);
                acc[mt] = mfma16(wh, xh, acc[mt]); acc[mt] = mfma16(wh, xl, acc[mt]); acc[mt] = mfma16(wl, xh, acc[mt]); } }
        ss += __shfl_xor(ss, 16); ss += __shfl_xor(ss, 32);
        const float rstd = 1.0f / sqrtf(ss * (1.f / DM) + EPS);
        am = fmaxf(am, __shfl_xor(am, 16)); am = fmaxf(am, __shfl_xor(am, 32));
        { const float qinv = am > 0.f ? 127.0f / am : 0.f; unsigned char* xq = F.XQ + (size_t)tok * DM;
#pragma unroll 4
            for (int ks = 0; ks < 32; ++ks) { const int k0 = 32 * ks + 8 * g;
                const f32x4 a = *(const GAS f32x4*)(xr + k0), b = *(const GAS f32x4*)(xr + k0 + 4);
                const float xv[8] = {a.x, a.y, a.z, a.w, b.x, b.y, b.z, b.w}; unsigned wlo = 0u, whi = 0u;
#pragma unroll
                for (int j = 0; j < 4; ++j) { wlo |= ((unsigned)(int)rintf(xv[j] * qinv) & 0xffu) << (8 * j); whi |= ((unsigned)(int)rintf(xv[4 + j] * qinv) & 0xffu) << (8 * j); }
                *(GAS u32x2*)(xq + k0) = (u32x2){wlo, whi}; } }
        const float rsq = rstd * am * (1.0f / 127.0f);
        float lg[8];
#pragma unroll
        for (int mt = 0; mt < 2; ++mt)
#pragma unroll
            for (int rg = 0; rg < 4; ++rg) lg[mt * 4 + rg] = acc[mt][rg] * rstd + F.b_router[16 * mt + 4 * g + rg];
        float tv[4]; int te[4];
#pragma unroll
        for (int k = 0; k < 4; ++k) {
            float bv = -3.0e38f; int bi = 0;
#pragma unroll
            for (int s = 0; s < 8; ++s) { const int e = 16 * (s >> 2) + 4 * g + (s & 3); if (lg[s] > bv) { bv = lg[s]; bi = e; } }
#pragma unroll
            for (int o = 16; o < 64; o <<= 1) { const float ov = __shfl_xor(bv, o); const int oi = __shfl_xor(bi, o); if (ov > bv || (ov == bv && oi < bi)) { bv = ov; bi = oi; } }
            tv[k] = bv; te[k] = bi;
#pragma unroll
            for (int s = 0; s < 8; ++s) { const int e = 16 * (s >> 2) + 4 * g + (s & 3); if (e == bi) lg[s] = -3.0e38f; }
        }
        const float e1 = __expf(tv[1] - tv[0]), e2 = __expf(tv[2] - tv[0]), e3 = __expf(tv[3] - tv[0]); const float den = 1.0f / (1.0f + e1 + e2 + e3);
        const float gk = ((g == 0) ? 1.0f : (g == 1) ? e1 : (g == 2) ? e2 : e3) * den; const int ek = (g == 0) ? te[0] : (g == 1) ? te[1] : (g == 2) ? te[2] : te[3];
        const int lpos = atomicAdd((int*)&hist[ek], 1);
        __syncthreads();
        if (tid < 32) { const int cnt = hist[tid]; wbase[tid] = cnt ? (int)__hip_atomic_fetch_add(F.ctl + CW_CNT + 64 * tid, (unsigned)cnt, RLX_AGENT) : 0; }
        __syncthreads();
        const int pos = wbase[ek] + lpos; const size_t li = (size_t)ek * T + pos;
        F.LIST[li] = tok; F.GWL[li] = gk; F.RS[li] = rsq; F.TE[tok * 4 + g] = ek; F.TP[tok * 4 + g] = pos;
        __syncthreads();
    }
}
__device__ __forceinline__ void moe_tables(Frame& F) {
    volatile LAS int* mpt = (volatile LAS int*)(F.lds + MOE_OFF); volatile LAS int* mcnt = mpt + 64;
    if (F.tid == 0) { int a = 0; for (int e = 0; e < 32; ++e) { const int c = (int)__hip_atomic_load(F.ctl + CW_CNT + 64 * e, RLX_AGENT); mcnt[e] = c; mpt[e] = a; a += (c + 255) >> 8; } mpt[32] = a; }
    __syncthreads();
}
__device__ __forceinline__ void p9_combine(Frame& F, bool dry = false) {
    volatile LAS int* mpt = (volatile LAS int*)(F.lds + MOE_OFF);
    const int gw = F.vcu * NWAVES + F.wave, NGW = F.G * NWAVES, lane = F.lane;
    for (int t = gw; t < T; t += NGW) {
        size_t srow[4];
#pragma unroll
        for (int k = 0; k < 4; ++k) { const int e = F.TE[t * 4 + k], p = F.TP[t * 4 + k]; srow[k] = ((size_t)mpt[e] * 256 + p) * 1024; }
        GAS f32x4* o = (GAS f32x4*)(F.out + (size_t)t * DM) + lane;
#pragma unroll
        for (int it = 0; it < 4; ++it) { f32x4 v = o[64 * it];
#pragma unroll
            for (int k = 0; k < 4; ++k) { const u32x2 y = *(const GAS u32x2*)(F.Y + srow[k] + it * 256 + lane * 4); v.x += bf_lo(y.x); v.y += bf_hi(y.x); v.z += bf_lo(y.y); v.w += bf_hi(y.y); }
            if (dry) ((GAS f32x4*)((float*)F.WGU + (size_t)t * DM) + lane)[64 * it] = v; else o[64 * it] = v; }
    }
}

struct Args { const void* in[20]; float* out; unsigned char* ws; int ph_lo, ph_hi; };
__global__ void __launch_bounds__(NWAVES * 64, 2) hybrid_fwd(Args args) {
    extern __shared__ __attribute__((aligned(16))) unsigned char lds[];
    Frame F;
    F.lds = (LAS unsigned char*)lds;
    F.MISC = (volatile LAS unsigned*)(F.lds + MISC_OFF);
    F.tid = threadIdx.x; F.lane = F.tid & 63; F.wave = __builtin_amdgcn_readfirstlane(F.tid >> 6);
    F.G = gridDim.x; { const int bx = blockIdx.x; F.vcu = (F.G % 8 == 0) ? (bx % 8) * (F.G / 8) + bx / 8 : bx; }
    unsigned char* ws = args.ws;
    F.ctl = (gu32*)(ws + WS_CTL);
    F.x = (const float*)args.in[0]; F.positions = (const int*)args.in[1]; F.norm1_g = (const float*)args.in[2]; F.w_in = (const float*)args.in[3];
    F.q_norm_g = (const float*)args.in[4]; F.k_norm_g = (const float*)args.in[5]; F.sgu_ln_g = (const float*)args.in[6]; F.sgu_ln_b = (const float*)args.in[7];
    F.w_spatial = (const float*)args.in[8]; F.b_spatial = (const float*)args.in[9]; F.w_branch_a = (const float*)args.in[10]; F.w_branch_b = (const float*)args.in[11];
    F.w_out = (const float*)args.in[12]; F.norm2_g = (const float*)args.in[13]; F.w_router = (const float*)args.in[14]; F.b_router = (const float*)args.in[15];
    F.w_gate_up = (const float*)args.in[16]; F.b_gate_up = (const float*)args.in[17]; F.w_down = (const float*)args.in[18]; F.b_down = (const float*)args.in[19];
    F.out = args.out;
    F.WIN = (bf16*)(ws + WS_WIN); F.WA = (bf16*)(ws + WS_WA); F.WB = (bf16*)(ws + WS_WB); F.WOUT = (bf16*)(ws + WS_WOUT); F.WSP = (bf16*)(ws + WS_WSP);
    F.WRH = (bf16*)(ws + WS_WRH); F.WRL = (bf16*)(ws + WS_WRL); F.WGU = (bf16*)(ws + WS_WGU); F.WD = (bf16*)(ws + WS_WD); F.XN = (bf16*)(ws + WS_XN);
    F.QKV = (bf16*)(ws + WS_QKV); F.Z = (bf16*)(ws + WS_Z); F.GT = (bf16*)(ws + WS_GT); F.ATT = (bf16*)(ws + WS_ATT); F.SGU = (bf16*)(ws + WS_SGU);
    F.ACT = (bf16*)(ws + WS_ACT); F.Y = (bf16*)(ws + WS_Y);
    F.ROPE = (float*)(ws + WS_ROPE); F.LSE = (float*)(ws + WS_LSE); F.GWL = (float*)(ws + WS_GWL); F.RS = (float*)(ws + WS_RS);
    F.WSC = (float*)(ws + WS_WSC); F.WSCIN = (float*)(ws + WS_WSCIN); F.XS = (float*)(ws + WS_XS); F.XQ = ws + WS_XN;
    F.TE = (int*)(ws + WS_TE); F.TP = (int*)(ws + WS_TP); F.LIST = (int*)(ws + WS_LIST);
    for (int u = F.tid; u < (LDS_BYTES - LDSCTL_OFF) / 4; u += NWAVES * 64) ((LAS unsigned*)(F.lds + LDSCTL_OFF))[u] = 0u;
    __syncthreads();
    XcdBarrier bar; bar.bar = (unsigned*)(F.ctl + CW_BAR); bar.x = 0; bar.st = nullptr;
    if (!MK_PER_PHASE) bar = xcd_barrier_post((unsigned*)(F.ctl + CW_BAR), F.MISC + 8);
    const int lo = args.ph_lo, hi = args.ph_hi;
#define IN(k) (lo <= (k) && (k) < hi)
#ifndef PROBE_WHICH
#define PROBE_WHICH -1
#endif
#ifndef PROBE_REP
#define PROBE_REP 0
#endif
#define REP(k) for (int rep_ = ((PROBE_REP >> (k)) & 1); rep_ >= 0; --rep_)
#define DRY (rep_ > 0)
#ifndef PROBE_PHASE
#define PROBE_PHASE -1
#endif
    unsigned long long pph_ = 0ull; (void)pph_;
#define PSTART(k) do { if ((k) == PROBE_PHASE) pph_ = rt(); } while (0)
#define SEAM(k) do { if (!MK_PER_PHASE && IN(k) && IN((k) + 1)) xcd_barrier(bar); if ((k) == PROBE_PHASE && F.tid == 0) *(LAS unsigned*)(F.lds + 131072 + 256) += (unsigned)(rt() - pph_); } while (0)
    bf16* const M1 = F.XN; bf16* const MERGED = F.Z;
    PG8_LAS unsigned* toktab = (PG8_LAS unsigned*)(F.lds + TOKTAB_OFF);
    volatile PG8_LAS int* mpt = (volatile PG8_LAS int*)(F.lds + MOE_OFF); volatile PG8_LAS int* mcnt = mpt + 64;

    if (IN(0)) { PSTART(0); REP(0) p0_prologue(F); SEAM(0); }
    if (IN(1)) { PSTART(1); REP(1) {
        pg8::Gemm g{(const bf16*)F.XQ, F.WIN, T, INW, DM / 2}; pg8::StaticOrder S; S.init(T, INW, F.G, (int)blockIdx.x);
        pg8::EpiProj E{F.XS, F.WSCIN, F.QKV, F.Z, F.GT};
        pg8::gemm_phase<pg8::EpiProj, pg8::StaticOrder, PG8_ALIGN, true, false, true>(F.lds + RING_OFF, g, S, E, nullptr, nullptr, PROBE_WHICH == 1); }
        SEAM(1);
    }
    if (IN(2)) { PSTART(2); REP(2) p1b_qknorm(F, DRY); SEAM(2); }
    if (IN(3)) { PSTART(3); REP(3) p2_attention(F); SEAM(3); }
    if (IN(4)) { PSTART(4); REP(4) p3_alpha(F, DRY); REP(11) p3_sgu(F); SEAM(4); }
    if (IN(5)) { PSTART(5); REP(5) {
        pg8::StaticOrder S; S.init(T, DM, F.G, (int)blockIdx.x);
        { pg8::Gemm g{F.ATT, F.WA, T, DM, AW}; pg8::EpiGate<false> E{F.GT, 0, nullptr, M1};
          pg8::gemm_phase<pg8::EpiGate<false>, pg8::StaticOrder, PG8_ALIGN, PG8_SP2>(F.lds + RING_OFF, g, S, E); }
        VM_WAIT(); __builtin_amdgcn_fence(__ATOMIC_SEQ_CST, "agent"); VM_WAIT(); __syncthreads();
        { pg8::Gemm g{F.SGU, F.WB, T, DM, AW}; pg8::EpiGate<true> E{F.GT, 1024, M1, MERGED};
          pg8::gemm_phase<pg8::EpiGate<true>, pg8::StaticOrder, PG8_ALIGN, PG8_SP2>(F.lds + RING_OFF, g, S, E); } }
        SEAM(5);
    }
    if (IN(6)) { PSTART(6); REP(6) {
        pg8::Gemm g{MERGED, F.WOUT, T, DM, DM}; pg8::StaticOrder S; S.init(T, DM, F.G, (int)blockIdx.x);
        pg8::EpiResid E{F.x, F.out};
        pg8::gemm_phase<pg8::EpiResid, pg8::StaticOrder, PG8_ALIGN, PG8_SP2>(F.lds + RING_OFF, g, S, E); }
        SEAM(6);
    }
    if (IN(7)) { PSTART(7); p6_router(F); SEAM(7); }
    if (IN(8)) { PSTART(8);
        moe_tables(F); REP(8) {
        pg8::Gemm g{(const bf16*)F.XQ, F.WGU, 0, 0, DM / 2}; pg8::MoeOrder S; S.init(mpt, mcnt, 8, F.G, (int)blockIdx.x, T);
        pg8::EpiSwiglu E{F.RS, F.WSC, F.b_gate_up, F.ACT};
        pg8::gemm_phase<pg8::EpiSwiglu, pg8::MoeOrder, PG8_ALIGN, true, true, true>(F.lds + RING_OFF, g, S, E, toktab, F.LIST, PROBE_WHICH == 8); }
        SEAM(8);
    }
    if (IN(9)) { PSTART(9);
        moe_tables(F); REP(9) {
        pg8::Gemm g{F.ACT, F.WD, 0, 0, DM}; pg8::MoeOrder S; S.init(mpt, mcnt, 4, F.G, (int)blockIdx.x, T);
        pg8::EpiDown E{F.GWL, F.b_down, F.Y};
        pg8::gemm_phase<pg8::EpiDown, pg8::MoeOrder, PG8_ALIGN, PG8_SP2>(F.lds + RING_OFF, g, S, E, nullptr, nullptr, PROBE_WHICH == 9); }
        SEAM(9);
    }
    if (IN(10)) { moe_tables(F); REP(10) p9_combine(F, DRY); }
#ifdef PG8_PROBE
    if (blockIdx.x == 0 && F.tid == 0) { const unsigned ticks = *(LAS unsigned*)(F.lds + 131072 + 256); const unsigned long long t0 = rt(); while (rt() - t0 < (unsigned long long)ticks) __builtin_amdgcn_s_sleep(8); }
#endif
#undef IN
#undef SEAM
}

extern "C" void kernel_launch(void* const* d_in, const int* in_sizes, int n_in, void* d_out, int out_size, void* d_ws, size_t ws_size, hipStream_t stream) {
    static int grid = 0;
    if (grid == 0) {
        if (n_in != 20 || out_size != T * DM || ws_size < WS_END) { fprintf(stderr, "kernel_launch: unexpected shapes (n_in %d, out %d, ws %zu)\n", n_in, out_size, ws_size); grid = -1; return; }
        int dev = 0, cus = 0;
        if (hipGetDevice(&dev) != hipSuccess || hipDeviceGetAttribute(&cus, hipDeviceAttributeMultiprocessorCount, dev) != hipSuccess) { grid = -1; return; }
        if (hipFuncSetAttribute((const void*)hybrid_fwd, hipFuncAttributeMaxDynamicSharedMemorySize, LDS_BYTES) != hipSuccess) { fprintf(stderr, "kernel_launch: hipFuncSetAttribute failed\n"); grid = -1; return; }
        int per_cu = 0;
        if (hipOccupancyMaxActiveBlocksPerMultiprocessor(&per_cu, (const void*)hybrid_fwd, NWAVES * 64, LDS_BYTES) != hipSuccess || per_cu < 1) fprintf(stderr, "kernel_launch: occupancy query reports %d\n", per_cu);
        (void)hipGetLastError();
        grid = cus;
    }
    if (grid < 0) return;
    if (hipMemsetAsync((char*)d_ws + WS_CTL, 0, CTL_ZERO_BYTES, stream) != hipSuccess) return;
    Args a{};
    for (int i = 0; i < 20; ++i) a.in[i] = d_in[i];
    a.out = (float*)d_out; a.ws = (unsigned char*)d_ws;
#if MK_PER_PHASE
    for (int p = 0; p < N_PHASES; ++p) { a.ph_lo = p; a.ph_hi = p + 1; hipLaunchKernelGGL(hybrid_fwd, dim3(grid), dim3(NWAVES * 64), LDS_BYTES, stream, a); }
#else
    a.ph_lo = 0; a.ph_hi = N_PHASES;
    hipLaunchKernelGGL(hybrid_fwd, dim3(grid), dim3(NWAVES * 64), LDS_BYTES, stream, a);
#endif
}
```

```cpp
#include <hip/hip_runtime.h>
#include <cstdio>
#include <cstdint>
namespace pg8 {
#define PG8_LAS __attribute__((address_space(3)))
typedef unsigned short bf16_t;
typedef short bf16x8 __attribute__((ext_vector_type(8)));
typedef float f32x4 __attribute__((ext_vector_type(4)));
typedef unsigned u32x4 __attribute__((ext_vector_type(4)));
constexpr int BM = 256, BK = 64, HALF = 128, HTB = HALF * BK * 2  , STAGE_BYTES = 8 * HTB, NXCD = 8, WGM = 8;

__host__ __device__ __forceinline__ int lds_byte(int r, int c) { const int st = (r >> 4) * 2 + (c >> 5), rr = r & 15, cc = c & 31, ob = rr * 64 + cc * 2; return st * 1024 + (ob ^ (((ob >> 9) & 1) << 5)); }
__host__ __device__ __forceinline__ void stage_rc(int b, int& R, int& C) { const int st = b / 1024, sb = b % 1024, swz = sb ^ (((sb >> 9) & 1) << 5); R = (st >> 1) * 16 + swz / 64; C = (st & 1) * 32 + (swz % 64) / 2; }
__host__ __device__ __forceinline__ int perm32(int rho) { const int n = rho >> 4, i = rho & 15; return 8 * (i >> 2) + 4 * n + (i & 3); }

struct Unit { int pm, pn, gl, gn, e, ob; };
struct Gemm { const bf16_t* A; const bf16_t* Bt; int M, N, K; };

struct StaticOrder {
    int nM, nN, nwg, G, c;
    __host__ __device__ void init(int M, int N, int G_, int c_) { nM = M / BM; nN = N / BM; nwg = nM * nN; G = G_; c = c_; }
    __host__ __device__ bool next(int i, Unit& u) const {
        const long L = (long)i * G + c; if (L >= nwg) return false;
        int wgid = (int)L; { const int q = nwg / NXCD, r = nwg % NXCD, xcd = wgid % NXCD, off = wgid / NXCD; wgid = (xcd < r ? xcd * (q + 1) : r * (q + 1) + (xcd - r) * q) + off; }
        const int nig = WGM * nN, gid = wgid / nig, fm = gid * WGM, gsz = (nM - fm) < WGM ? (nM - fm) : WGM;
        u.pm = fm + ((wgid % nig) % gsz); u.pn = (wgid % nig) / gsz; u.gl = 0; u.gn = 0; u.e = 0; u.ob = 0; return true;
    }
    __device__ __forceinline__ void a_ready(const Unit&) const {}
    __device__ __forceinline__ void done(const Unit&) const {}
};

__device__ __forceinline__ unsigned cvt_pk_bf16(float lo, float hi) { unsigned r; asm volatile("v_cvt_pk_bf16_f32 %0, %1, %2" : "=v"(r) : "v"(lo), "v"(hi)); return r; }
typedef float f32x2 __attribute__((ext_vector_type(2)));
__device__ __forceinline__ f32x2 gelu_pk(f32x2 v) {
    const f32x2 av = __builtin_elementwise_abs(v), d = av * 0.2316418882f + 1.0f;
    f32x2 t; t.x = __builtin_amdgcn_rcpf(d.x); t.y = __builtin_amdgcn_rcpf(d.y);
    f32x2 q = t * 0.5307027145f + (-0.7265760135f); q = q * t + 0.7107068705f; q = q * t + (-0.142248368f); q = q * t + 0.127414796f; q = q * t;
    const f32x2 s = (v * v) * (-0.72134752044f);
    f32x2 e; e.x = __builtin_amdgcn_exp2f(s.x); e.y = __builtin_amdgcn_exp2f(s.y);
    const f32x2 m = v * (q * e), r = v - m;
    f32x2 o; o.x = v.x < 0.f ? m.x : r.x; o.y = v.y < 0.f ? m.y : r.y; return o;
}

template <int ACT  > struct EpiBf16 {
    static constexpr bool PERM = true, AFTER_DRAIN = false; static_assert(ACT == 0 || ACT == 1, "EpiBf16: ACT is 0 (none) or 1 (gelu_pk)");
    bf16_t* O; int ldc; const float* bias; int split_cols; size_t split_stride; float scale0;
    __device__ __forceinline__ void operator()(const f32x4 (&acc)[2][2][4][2], const Unit& u, int wr, int wc, int fr, int fq) const {
        const int row0 = u.pm * BM + wr * 64 + fr; int colt = u.pn * BM; bf16_t* base = O;
        float sc = 1.f; if (split_cols) { const int t = colt / split_cols; base += (size_t)t * split_stride; colt -= t * split_cols; if (t == 0) sc = scale0; }
        const int col0 = colt + wc * 32 + 8 * fq, bcol0 = u.pn * BM + wc * 32 + 8 * fq;
        f32x4 bv[2][2];
#pragma unroll
        for (int bj = 0; bj < 2; ++bj)
#pragma unroll
            for (int n = 0; n < 2; ++n) bv[bj][n] = bias ? *(const f32x4*)(bias + bcol0 + bj * HALF + 4 * n) : (f32x4){0.f, 0.f, 0.f, 0.f};
#pragma unroll
        for (int ai = 0; ai < 2; ++ai)
#pragma unroll
            for (int m = 0; m < 4; ++m) { bf16_t* rowp = base + (size_t)(row0 + ai * HALF + m * 16) * ldc + col0;
#pragma unroll
                for (int bj = 0; bj < 2; ++bj) { f32x4 v0 = acc[ai][bj][m][0] + bv[bj][0], v1 = acc[ai][bj][m][1] + bv[bj][1];
                    if (ACT == 1) { f32x2 a = gelu_pk((f32x2){v0[0], v0[1]}), b = gelu_pk((f32x2){v0[2], v0[3]}), c = gelu_pk((f32x2){v1[0], v1[1]}), d = gelu_pk((f32x2){v1[2], v1[3]});
                        v0 = (f32x4){a.x, a.y, b.x, b.y}; v1 = (f32x4){c.x, c.y, d.x, d.y}; }
                    v0 = v0 * sc; v1 = v1 * sc; u32x4 w; w.x = cvt_pk_bf16(v0[0], v0[1]); w.y = cvt_pk_bf16(v0[2], v0[3]); w.z = cvt_pk_bf16(v1[0], v1[1]); w.w = cvt_pk_bf16(v1[2], v1[3]);
                    *(u32x4*)(rowp + bj * HALF) = w; } }
    }
};

struct PanelStats {
    unsigned* xbuf;
    unsigned* cnt;
    unsigned* tmo;
    int ntn; float eps;
    unsigned code;
    __device__ __forceinline__ bool run(const f32x4 (&v)[2][2][4][2], const Unit& u, int wr, int wc, int fr, int fq, PG8_LAS unsigned char* lds, int wid, int lane) const {
        typedef float f32x2v __attribute__((ext_vector_type(2)));
        PG8_LAS f32x2v* P = (PG8_LAS f32x2v*)lds;
        PG8_LAS f32x2v* S = (PG8_LAS f32x2v*)(lds + 8192);
        PG8_LAS unsigned* flag = (PG8_LAS unsigned*)(lds + 8192 + 2048);
#pragma unroll
        for (int ai = 0; ai < 2; ++ai)
#pragma unroll
            for (int m = 0; m < 4; ++m) {
                float s = 0.f;
#pragma unroll
                for (int bj = 0; bj < 2; ++bj)
#pragma unroll
                    for (int n = 0; n < 2; ++n) { const f32x4 x = v[ai][bj][m][n]; s += (x[0] + x[1]) + (x[2] + x[3]); }
                s += __shfl_xor(s, 16); s += __shfl_xor(s, 32);
                const float mw = s * (1.0f / 64.0f); float q = 0.f;
#pragma unroll
                for (int bj = 0; bj < 2; ++bj)
#pragma unroll
                    for (int n = 0; n < 2; ++n) { const f32x4 d = v[ai][bj][m][n] - mw; q += (d[0] * d[0] + d[1] * d[1]) + (d[2] * d[2] + d[3] * d[3]); }
                q += __shfl_xor(q, 16); q += __shfl_xor(q, 32);
                if (fq == 0) P[(ai * HALF + wr * 64 + m * 16 + fr) * 4 + wc] = (f32x2v){mw, q};
            }
        asm volatile("s_waitcnt lgkmcnt(0)" ::: "memory"); __builtin_amdgcn_s_barrier(); asm volatile("" ::: "memory");
#if defined(BROKEN_EXCHANGE_NO_WAIT)
#warning BROKEN CONTROL BUILD: the row-statistics exchange does not wait; results are wrong by design
        if (blockIdx.x >= 64) { const long long t0_ = clock64(); while (clock64() - t0_ < 60000) __builtin_amdgcn_s_sleep(8); }
#endif
        const int row = wid * 32 + (lane & 31);
        if (lane < 32) {
            const f32x2v a = P[row * 4 + 0], b = P[row * 4 + 1], c = P[row * 4 + 2], d = P[row * 4 + 3];
            const float mt = (a.x + b.x + c.x + d.x) * 0.25f;
            const float da = a.x - mt, db = b.x - mt, dc = c.x - mt, dd = d.x - mt;
            const float m2 = (a.y + b.y) + (c.y + d.y) + 64.0f * ((da * da + db * db) + (dc * dc + dd * dd));
            unsigned long long* slot = (unsigned long long*)xbuf + ((size_t)(u.pm * BM + row) * 4 + u.pn);
            __hip_atomic_store(slot, ((unsigned long long)__float_as_uint(m2) << 32) | __float_as_uint(mt), __ATOMIC_RELAXED, __HIP_MEMORY_SCOPE_AGENT);
        }
        asm volatile("s_waitcnt vmcnt(0)" ::: "memory");
        if (lane == 0) __hip_atomic_fetch_add(cnt + 64 * u.pm, 1u, __ATOMIC_RELAXED, __HIP_MEMORY_SCOPE_AGENT);
        if (wid == 0) {
            bool dead = false; const unsigned long long t0 = __builtin_amdgcn_s_memrealtime(); const unsigned want = 8u * (unsigned)ntn;
            for (;;) {
#if defined(BROKEN_EXCHANGE_NO_WAIT)
                break;
#endif
                if ((unsigned)__builtin_amdgcn_readfirstlane(__hip_atomic_load(cnt + 64 * u.pm, __ATOMIC_RELAXED, __HIP_MEMORY_SCOPE_AGENT)) >= want) break;
                if (__builtin_amdgcn_s_memrealtime() - t0 > 2000000ull) {
                    if (lane == 0) { unsigned expect = 0u; __hip_atomic_compare_exchange_strong(tmo + 1, &expect, code | (unsigned)(u.pm & 0xff), __ATOMIC_RELAXED, __ATOMIC_RELAXED, __HIP_MEMORY_SCOPE_AGENT);
                                     __hip_atomic_store(tmo, 1u, __ATOMIC_RELAXED, __HIP_MEMORY_SCOPE_AGENT); }
                    dead = true; break; }
                __builtin_amdgcn_s_sleep(2);
            }
            __builtin_amdgcn_fence(__ATOMIC_ACQUIRE, "agent");
            if (lane == 0) flag[0] = dead ? 1u : 0u;
        }
        asm volatile("s_waitcnt vmcnt(0) lgkmcnt(0)" ::: "memory"); __builtin_amdgcn_s_barrier(); asm volatile("" ::: "memory");
        const bool bad = flag[0] != 0u;
        if (lane < 32) {
            const unsigned long long* slot = (const unsigned long long*)xbuf + (size_t)(u.pm * BM + row) * 4; float mt[4], m2[4]; float ms = 0.f;
#pragma unroll
            for (int t = 0; t < 4; ++t) { if (t < ntn) { const unsigned long long w = __hip_atomic_load(slot + t, __ATOMIC_RELAXED, __HIP_MEMORY_SCOPE_AGENT); mt[t] = __uint_as_float((unsigned)w); m2[t] = __uint_as_float((unsigned)(w >> 32)); } else { mt[t] = 0.f; m2[t] = 0.f; } ms += mt[t]; }
            const float mean = ms / (float)ntn; float q = 0.f;
#pragma unroll
            for (int t = 0; t < 4; ++t) if (t < ntn) { const float dm = mt[t] - mean; q += m2[t] + 256.0f * dm * dm; }
            S[row] = (f32x2v){mean, 1.0f / sqrtf(q / (256.0f * (float)ntn) + eps)};
        }
        asm volatile("s_waitcnt lgkmcnt(0)" ::: "memory"); __builtin_amdgcn_s_barrier(); asm volatile("" ::: "memory");
        return bad;
    }
};
struct EpiLnRes {
    static constexpr bool PERM = false, AFTER_DRAIN = true;
    const float* base; float* out; int ldc; const float* bias; PanelStats st; unsigned poison;
    __device__ __forceinline__ void fused(f32x4 (&acc)[2][2][4][2], const Unit& u, int wr, int wc, int fr, int fq, PG8_LAS unsigned char* lds, int wid, int lane) const {
        typedef float f32x2v __attribute__((ext_vector_type(2)));
        const PG8_LAS f32x2v* S = (const PG8_LAS f32x2v*)(lds + 8192);
        const int col0 = u.pn * BM + wc * 32 + 4 * fq;
#pragma unroll
        for (int bj = 0; bj < 2; ++bj)
#pragma unroll
            for (int n = 0; n < 2; ++n) { const f32x4 bv = bias ? *(const f32x4*)(bias + col0 + bj * HALF + n * 16) : (f32x4){0.f, 0.f, 0.f, 0.f};
#pragma unroll
                for (int ai = 0; ai < 2; ++ai)
#pragma unroll
                    for (int m = 0; m < 4; ++m) acc[ai][bj][m][n] += bv; }
        f32x4 pre[4][2][2];
#pragma unroll
        for (int m = 0; m < 4; ++m) { const size_t off = (size_t)(u.pm * BM + wr * 64 + m * 16 + fr) * ldc + col0;
#pragma unroll
            for (int bj = 0; bj < 2; ++bj)
#pragma unroll
                for (int n = 0; n < 2; ++n) pre[m][bj][n] = *(const f32x4*)(base + off + bj * HALF + n * 16); }
        const bool bad = st.run(acc, u, wr, wc, fr, fq, lds, wid, lane) || poison != 0u;
        const float qnan = __builtin_nanf("");
#pragma unroll
        for (int ai = 0; ai < 2; ++ai)
#pragma unroll
            for (int m = 0; m < 4; ++m) { const int r = ai * HALF + wr * 64 + m * 16 + fr; const f32x2v sr = S[r]; const size_t off = (size_t)(u.pm * BM + r) * ldc + col0;
#pragma unroll
                for (int bj = 0; bj < 2; ++bj)
#pragma unroll
                    for (int n = 0; n < 2; ++n) { const f32x4 bs = ai == 0 ? pre[m][bj][n] : *(const f32x4*)(base + off + bj * HALF + n * 16); f32x4 o = bs + (acc[ai][bj][m][n] - sr.x) * sr.y;
                        if (bad) o = (f32x4){qnan, qnan, qnan, qnan}; *(f32x4*)(out + off + bj * HALF + n * 16) = o; }
                if (m & 1) asm volatile("" ::: "memory"); }
    }
};
struct EpiLnResLn {
    static constexpr bool PERM = false, AFTER_DRAIN = true;
    const float* base; float* out; bf16_t* xn; int ldc; const float* bias; PanelStats st1, st2; unsigned poison;
    __device__ __forceinline__ void fused(f32x4 (&acc)[2][2][4][2], const Unit& u, int wr, int wc, int fr, int fq, PG8_LAS unsigned char* lds, int wid, int lane) const {
        typedef float f32x2v __attribute__((ext_vector_type(2))); typedef unsigned u32x2v __attribute__((ext_vector_type(2)));
        const PG8_LAS f32x2v* S = (const PG8_LAS f32x2v*)(lds + 8192);
        const int col0 = u.pn * BM + wc * 32 + 4 * fq;
#pragma unroll
        for (int bj = 0; bj < 2; ++bj)
#pragma unroll
            for (int n = 0; n < 2; ++n) { const f32x4 bv = bias ? *(const f32x4*)(bias + col0 + bj * HALF + n * 16) : (f32x4){0.f, 0.f, 0.f, 0.f};
#pragma unroll
                for (int ai = 0; ai < 2; ++ai)
#pragma unroll
                    for (int m = 0; m < 4; ++m) acc[ai][bj][m][n] += bv; }
        bool bad = st1.run(acc, u, wr, wc, fr, fq, lds, wid, lane) || poison != 0u;
        const float qnan = __builtin_nanf("");
#pragma unroll
        for (int ai = 0; ai < 2; ++ai)
#pragma unroll
            for (int m = 0; m < 4; ++m) { const int r = ai * HALF + wr * 64 + m * 16 + fr; const f32x2v sr = S[r]; const size_t off = (size_t)(u.pm * BM + r) * ldc + col0;
#pragma unroll
                for (int bj = 0; bj < 2; ++bj)
#pragma unroll
                    for (int n = 0; n < 2; ++n) { const f32x4 bs = *(const f32x4*)(base + off + bj * HALF + n * 16); acc[ai][bj][m][n] = bs + (acc[ai][bj][m][n] - sr.x) * sr.y; }
                asm volatile("" : "+v"(acc[ai][0][m][0]), "+v"(acc[ai][0][m][1]), "+v"(acc[ai][1][m][0]), "+v"(acc[ai][1][m][1]));
                if (m & 1) asm volatile("" ::: "memory"); }
        const bool bad1 = bad;
        bad = st2.run(acc, u, wr, wc, fr, fq, lds, wid, lane) || bad;
#pragma unroll
        for (int ai = 0; ai < 2; ++ai)
#pragma unroll
            for (int m = 0; m < 4; ++m) { const int r = ai * HALF + wr * 64 + m * 16 + fr; const f32x2v sr = S[r]; const size_t off = (size_t)(u.pm * BM + r) * ldc + col0;
#pragma unroll
                for (int bj = 0; bj < 2; ++bj)
#pragma unroll
                    for (int n = 0; n < 2; ++n) { const f32x4 x1 = acc[ai][bj][m][n]; *(f32x4*)(out + off + bj * HALF + n * 16) = bad1 ? (f32x4){qnan, qnan, qnan, qnan} : x1;
                        const f32x4 o = (x1 - sr.x) * sr.y; u32x2v w; w.x = cvt_pk_bf16(o[0], o[1]); w.y = cvt_pk_bf16(o[2], o[3]);
                        if (bad) { w.x = 0x7fc07fc0u; w.y = 0x7fc07fc0u; } *(u32x2v*)(xn + off + bj * HALF + n * 16) = w; }
                asm volatile("" ::: "memory"); }
    }
};

typedef int i32x4 __attribute__((ext_vector_type(4)));
template <bool I8> struct AccSel { typedef f32x4 type; };
template <> struct AccSel<true> { typedef i32x4 type; };
typedef long i64x2 __attribute__((ext_vector_type(2)));
template <class Epi, class Sched, bool ALIGN_EPI = false, bool SP2 = false, bool GATHER = false, int OPK = 0>
__device__ __forceinline__ void gemm_phase(PG8_LAS unsigned char* lds, const Gemm g, const Sched& S, const Epi& E, PG8_LAS unsigned* toktab = nullptr, const int* glist = nullptr, bool probe = false) {
    unsigned long long pacc_ = 0ull, pt0_ = 0ull; (void)pt0_;
    static_assert(!GATHER || SP2, "GATHER needs the SP2 loop (lgkmcnt(0)-only waits)");
    const int tid = threadIdx.x, wid = __builtin_amdgcn_readfirstlane(tid >> 6), lane = tid & 63, wr = wid >> 2, wc = wid & 3, fr = lane & 15, fq = lane >> 4;
    const int K = g.K, nt = K / BK;
    unsigned voffA[2], voffB[2];
#pragma unroll
    for (int i = 0; i < 2; ++i) { int R, C; stage_rc(tid * 16 + i * 8192, R, C); const int Rb = Epi::PERM ? ((R & ~31) + perm32(R & 31)) : R;
        voffA[i] = (unsigned)(R * K + C) * 2u; voffB[i] = (unsigned)(Rb * K + C) * 2u; }
    const size_t kstep = (size_t)(BK * 2);
    const size_t hstep = (size_t)HALF * K * 2;
    const size_t tstep = 2 * hstep;
    const unsigned ldsw = (unsigned)wid * 1024u;
    const int aoff = lds_byte(wr * 64 + fr, fq * 8), boff = lds_byte(wc * 32 + fr, fq * 8);
#define PG8_SA(b, h) (((b) * 2 + (h)) * HTB)
#define PG8_SB(b, h) ((4 + (b) * 2 + (h)) * HTB)
#define PG8_STAGE(bufoff, gbase, voff) do { _Pragma("unroll") for (int _i = 0; _i < 2; ++_i) \
        __builtin_amdgcn_global_load_lds((const unsigned*)((const char*)(gbase) + (voff)[_i]), (PG8_LAS unsigned*)(lds + (bufoff) + ldsw + _i * 8192), 16, 0, 0); } while (0)
#define PG8_STAGEA(bufoff, gbase, h) do { if constexpr (GATHER) { PG8_STAGE(bufoff, gbase, oA[h]); } else { PG8_STAGE(bufoff, (gbase) + (h) * hstep, voffA); } } while (0)
#define PG8_EXTRACT(U, bufsel) do { _Pragma("unroll") for (int h_ = 0; h_ < 2; ++h_) _Pragma("unroll") for (int i_ = 0; i_ < 2; ++i_) { const int row_ = h_ * HALF + rowA[i_]; \
        unsigned tk_ = toktab[(bufsel) * 512 + row_]; if (row_ >= (U).gn) tk_ = 0u; oA[h_][i_] = tk_ * (unsigned)(K * 2) + colA2[i_]; } } while (0)
#define PG8_TOKLOAD(U, bufsel) __builtin_amdgcn_global_load_lds((const unsigned*)(glist + (U).gl + tid), toktab + (bufsel) * 512 + wid * 64, 4, 0, 0)
#define PG8_LDA(dst, b, h) do { _Pragma("unroll") for (int m = 0; m < 4; ++m) _Pragma("unroll") for (int k = 0; k < 2; ++k) dst[m][k] = *(const PG8_LAS bf16x8*)(lds + PG8_SA(b, h) + aoff + m * 2048 + k * 1024); } while (0)
#define PG8_LDB(dst, b, h) do { _Pragma("unroll") for (int n = 0; n < 2; ++n) _Pragma("unroll") for (int k = 0; k < 2; ++k) dst[n][k] = *(const PG8_LAS bf16x8*)(lds + PG8_SB(b, h) + boff + n * 2048 + k * 1024); } while (0)
#define PG8_MMA(ai, bj, At, Bt) do { __builtin_amdgcn_s_setprio(1); _Pragma("unroll") for (int m = 0; m < 4; ++m) _Pragma("unroll") for (int n = 0; n < 2; ++n) _Pragma("unroll") for (int k = 0; k < 2; ++k) { \
        if constexpr (OPK == 1) acc[ai][bj][m][n] = __builtin_amdgcn_mfma_i32_16x16x64_i8(__builtin_bit_cast(i32x4, Bt[n][k]), __builtin_bit_cast(i32x4, At[m][k]), acc[ai][bj][m][n], 0, 0, 0); \
        else if constexpr (OPK == 2) { const i64x2 b8_ = __builtin_bit_cast(i64x2, Bt[n][k]), a8_ = __builtin_bit_cast(i64x2, At[m][k]); \
            acc[ai][bj][m][n] = __builtin_amdgcn_mfma_f32_16x16x32_fp8_fp8(b8_[0], a8_[0], acc[ai][bj][m][n], 0, 0, 0); acc[ai][bj][m][n] = __builtin_amdgcn_mfma_f32_16x16x32_fp8_fp8(b8_[1], a8_[1], acc[ai][bj][m][n], 0, 0, 0); } \
        else acc[ai][bj][m][n] = __builtin_amdgcn_mfma_f32_16x16x32_bf16(Bt[n][k], At[m][k], acc[ai][bj][m][n], 0, 0, 0); } __builtin_amdgcn_s_setprio(0); } while (0)
#define PG8_WAIT_V(n) asm volatile("s_waitcnt vmcnt(" #n ")" ::: "memory")
#define PG8_WAIT_L(n) asm volatile("s_waitcnt lgkmcnt(" #n ")" ::: "memory")
#define PG8_BAR __builtin_amdgcn_s_barrier()
#define PG8_SCHED __builtin_amdgcn_sched_barrier(0)
    Unit cur, nxt; int ui = 0;
    if (!S.next(0, cur)) return;
    typedef typename AccSel<OPK == 1>::type acc_t;
    acc_t acc[2][2][4][2];
#pragma unroll
    for (int a = 0; a < 2; ++a)
#pragma unroll
        for (int b = 0; b < 2; ++b)
#pragma unroll
            for (int m = 0; m < 4; ++m)
#pragma unroll
                for (int n = 0; n < 2; ++n) acc[a][b][m][n] = (acc_t){0, 0, 0, 0};
    bf16x8 At[4][2], B0[2][2], B1[2][2];
    const char* cA = GATHER ? (const char*)g.A : (const char*)g.A + (size_t)cur.pm * tstep; const char* cB = (const char*)g.Bt + (size_t)cur.pn * tstep;
    S.a_ready(cur);
    unsigned oA[2][2] = {{0u, 0u}, {0u, 0u}}; int rowA[2] = {0, 0}; unsigned colA2[2] = {0u, 0u};
    if constexpr (GATHER) {
#pragma unroll
        for (int i = 0; i < 2; ++i) { int R, C; stage_rc(tid * 16 + i * 8192, R, C); rowA[i] = R; colA2[i] = (unsigned)C * 2u; }
        Unit n1; const bool h1 = S.next(1, n1);
        PG8_TOKLOAD(cur, 0); if (h1) PG8_TOKLOAD(n1, 1);
        PG8_WAIT_V(0); PG8_BAR; asm volatile("" ::: "memory");
        PG8_EXTRACT(cur, 0); PG8_WAIT_L(0);
    }
    if constexpr (SP2) {
        PG8_STAGE(PG8_SB(0, 0), cB, voffB); PG8_STAGE(PG8_SB(0, 1), cB + hstep, voffB); PG8_STAGEA(PG8_SA(0, 0), cA, 0); PG8_STAGEA(PG8_SA(0, 1), cA, 1);
        if (wr == 1) PG8_BAR;
        PG8_WAIT_V(2); PG8_BAR;
        PG8_STAGE(PG8_SB(1, 0), cB + kstep, voffB); PG8_STAGEA(PG8_SA(1, 0), cA + kstep, 0); PG8_STAGE(PG8_SB(1, 1), cB + hstep + kstep, voffB);
        PG8_WAIT_V(6); PG8_BAR;
    } else {
        PG8_STAGE(PG8_SB(0, 0), cB, voffB); PG8_STAGEA(PG8_SA(0, 0), cA, 0); PG8_STAGE(PG8_SB(0, 1), cB + hstep, voffB); PG8_STAGEA(PG8_SA(0, 1), cA, 1);
        if (wr == 1) PG8_BAR;
        PG8_WAIT_V(4); PG8_BAR;
        PG8_STAGE(PG8_SB(1, 0), cB + kstep, voffB); PG8_STAGEA(PG8_SA(1, 0), cA + kstep, 0); PG8_STAGE(PG8_SB(1, 1), cB + hstep + kstep, voffB);
        PG8_WAIT_V(6); PG8_BAR;
    }
    for (;;) {
        const bool has_next = S.next(ui + 1, nxt);
        const char* nA = (has_next && !GATHER) ? (const char*)g.A + (size_t)nxt.pm * tstep : cA; const char* nB = has_next ? (const char*)g.Bt + (size_t)nxt.pn * tstep : cB;
        for (int t = 0; t < nt; t += 2) {
            const bool last = (t == nt - 2);
            const char* a1 = cA + (size_t)(t + 1) * kstep;
            const char* a2 = last ? nA : cA + (size_t)(t + 2) * kstep; const char* b2 = last ? nB : cB + (size_t)(t + 2) * kstep;
            const char* a3 = a2 + kstep; const char* b3 = b2 + kstep;
            if (last && has_next) S.a_ready(nxt);
            if constexpr (SP2) {
            PG8_LDB(B0, 0, 0); PG8_LDB(B1, 0, 1); PG8_SCHED; PG8_LDA(At, 0, 0); PG8_STAGEA(PG8_SA(1, 1), a1, 1);
            if constexpr (GATHER) { if (last && has_next) { PG8_EXTRACT(nxt, (ui + 1) & 1); Unit n2; if (S.next(ui + 2, n2)) PG8_TOKLOAD(n2, ui & 1); } }
            PG8_WAIT_V(8); PG8_WAIT_L(0); PG8_BAR; PG8_MMA(0, 0, At, B0); PG8_MMA(0, 1, At, B1); PG8_BAR; PG8_SCHED;
            PG8_LDA(At, 0, 1); PG8_STAGE(PG8_SB(0, 0), b2, voffB); PG8_STAGE(PG8_SB(0, 1), b2 + hstep, voffB); PG8_STAGEA(PG8_SA(0, 0), a2, 0);
            PG8_WAIT_V(8); PG8_WAIT_L(0); PG8_BAR; PG8_MMA(1, 0, At, B0); PG8_MMA(1, 1, At, B1); PG8_BAR; PG8_SCHED;
            PG8_LDB(B0, 1, 0); PG8_LDB(B1, 1, 1); PG8_SCHED; PG8_LDA(At, 1, 0); PG8_STAGEA(PG8_SA(0, 1), a2, 1);
            PG8_WAIT_V(8); PG8_WAIT_L(0); PG8_BAR; PG8_MMA(0, 0, At, B0); PG8_MMA(0, 1, At, B1); PG8_BAR; PG8_SCHED;
            PG8_LDA(At, 1, 1); PG8_STAGE(PG8_SB(1, 0), b3, voffB); PG8_STAGE(PG8_SB(1, 1), b3 + hstep, voffB); PG8_STAGEA(PG8_SA(1, 0), a3, 0);
            PG8_WAIT_V(8); PG8_WAIT_L(0); PG8_BAR; PG8_MMA(1, 0, At, B0); PG8_MMA(1, 1, At, B1); PG8_BAR; PG8_SCHED;
            } else {
            PG8_LDB(B0, 0, 0); PG8_SCHED; PG8_LDA(At, 0, 0); PG8_STAGEA(PG8_SA(1, 1), a1, 1);
            PG8_WAIT_L(8); PG8_BAR; PG8_WAIT_L(0); PG8_MMA(0, 0, At, B0); PG8_BAR; PG8_SCHED;
            PG8_LDB(B1, 0, 1); PG8_STAGE(PG8_SB(0, 0), b2, voffB);
            PG8_BAR; PG8_WAIT_L(0); PG8_MMA(0, 1, At, B1); PG8_BAR;
            PG8_LDA(At, 0, 1); PG8_STAGEA(PG8_SA(0, 0), a2, 0);
            PG8_BAR; PG8_WAIT_L(0); PG8_MMA(1, 0, At, B0); PG8_BAR; PG8_SCHED;
            PG8_STAGE(PG8_SB(0, 1), b2 + hstep, voffB);
            PG8_WAIT_V(6); PG8_BAR; PG8_MMA(1, 1, At, B1); PG8_BAR;
            PG8_LDB(B0, 1, 0); PG8_SCHED; PG8_LDA(At, 1, 0); PG8_STAGEA(PG8_SA(0, 1), a2, 1);
            PG8_WAIT_L(8); PG8_BAR; PG8_WAIT_L(0); PG8_MMA(0, 0, At, B0); PG8_BAR; PG8_SCHED;
            PG8_LDB(B1, 1, 1); PG8_STAGE(PG8_SB(1, 0), b3, voffB);
            PG8_BAR; PG8_WAIT_L(0); PG8_MMA(0, 1, At, B1); PG8_BAR;
            PG8_LDA(At, 1, 1); PG8_STAGEA(PG8_SA(1, 0), a3, 0);
            PG8_BAR; PG8_WAIT_L(0); PG8_MMA(1, 0, At, B0); PG8_BAR; PG8_SCHED;
            PG8_STAGE(PG8_SB(1, 1), b3 + hstep, voffB);
            PG8_WAIT_V(6); PG8_BAR; PG8_MMA(1, 1, At, B1); PG8_BAR;
            }
        }
#ifdef PG8_PROBE
        pt0_ = __builtin_amdgcn_s_memrealtime();
#endif
        if constexpr (ALIGN_EPI) { if (wr == 0) PG8_BAR; }
        if constexpr (!Epi::AFTER_DRAIN) { E(acc, cur, wr, wc, fr, fq); S.done(cur); }
        if (!has_next) break;
#pragma unroll
        for (int a = 0; a < 2; ++a)
#pragma unroll
            for (int b = 0; b < 2; ++b)
#pragma unroll
                for (int m = 0; m < 4; ++m)
#pragma unroll
                    for (int n = 0; n < 2; ++n) acc[a][b][m][n] = (acc_t){0, 0, 0, 0};
        cur = nxt; cA = nA; cB = nB; ++ui;
        if constexpr (ALIGN_EPI) { if (wr == 1) PG8_BAR; }
#ifdef PG8_PROBE
        pacc_ += __builtin_amdgcn_s_memrealtime() - pt0_;
#endif
    }
    PG8_WAIT_V(0);
    if constexpr (!ALIGN_EPI) { if (wr == 0) PG8_BAR; }
    PG8_BAR;
    if constexpr (Epi::AFTER_DRAIN) { E.fused(acc, cur, wr, wc, fr, fq, lds, wid, lane); S.done(cur); }
#ifdef PG8_PROBE
    if (probe && tid == 0) *(PG8_LAS unsigned*)(lds + 131072 + 256) += (unsigned)pacc_;
#endif
#undef PG8_SA
#undef PG8_SB
#undef PG8_STAGE
#undef PG8_STAGEA
#undef PG8_EXTRACT
#undef PG8_TOKLOAD
#undef PG8_LDA
#undef PG8_LDB
#undef PG8_MMA
#undef PG8_WAIT_V
#undef PG8_WAIT_L
#undef PG8_BAR
#undef PG8_SCHED
}
}
namespace pg8 {
__device__ __forceinline__ float bf2f(unsigned short b) { return __uint_as_float((unsigned)b << 16); }
__device__ __forceinline__ float bflo(unsigned w) { return __uint_as_float(w << 16); }
__device__ __forceinline__ float bfhi(unsigned w) { return __uint_as_float(w & 0xffff0000u); }
__device__ __forceinline__ float sigmoidf_(float x) { return __builtin_amdgcn_rcpf(1.0f + __builtin_amdgcn_exp2f(-1.4426950408889634f * x)); }

struct EpiProj {
    static constexpr bool PERM = true, AFTER_DRAIN = false;
    const float* XS; const float* WSC; bf16_t* QKV; bf16_t* Z; bf16_t* GT;
    __device__ __forceinline__ void operator()(const i32x4 (&acc)[2][2][4][2], const Unit& u, int wr, int wc, int fr, int fq) const {
        const int row0 = u.pm * BM + wr * 64 + fr; const int pn = u.pn;
        bf16_t* base; int ldc, colt, mode;
        if (pn < 9) { base = QKV; ldc = 2304; colt = pn * 256; mode = 0; }
        else if (pn < 15) { base = Z; ldc = 1536; colt = (pn - 9) * 256; mode = 1; }
        else { base = GT; ldc = 2048; colt = (pn - 15) * 256; mode = 2; }
        const int col0 = colt + wc * 32 + 8 * fq;
        const float* ws = WSC + pn * 256 + wc * 32 + 8 * fq;
        f32x4 wv[2][2];
#pragma unroll
        for (int bj = 0; bj < 2; ++bj)
#pragma unroll
            for (int n = 0; n < 2; ++n) wv[bj][n] = *(const f32x4*)(ws + bj * HALF + 4 * n);
#pragma unroll
        for (int ai = 0; ai < 2; ++ai)
#pragma unroll
            for (int m = 0; m < 4; ++m) { const int r = row0 + ai * HALF + m * 16; const float xs = XS[r]; bf16_t* rowp = base + (size_t)r * ldc + col0;
#pragma unroll
                for (int bj = 0; bj < 2; ++bj) { f32x4 v0, v1;
#pragma unroll
                    for (int j = 0; j < 4; ++j) { v0[j] = (float)acc[ai][bj][m][0][j] * (xs * wv[bj][0][j]); v1[j] = (float)acc[ai][bj][m][1][j] * (xs * wv[bj][1][j]); }
                    if (mode == 1) { f32x2 a = gelu_pk((f32x2){v0[0], v0[1]}), b = gelu_pk((f32x2){v0[2], v0[3]}), c = gelu_pk((f32x2){v1[0], v1[1]}), d = gelu_pk((f32x2){v1[2], v1[3]});
                        v0 = (f32x4){a.x, a.y, b.x, b.y}; v1 = (f32x4){c.x, c.y, d.x, d.y}; }
                    else if (mode == 2) {
#pragma unroll
                        for (int j = 0; j < 4; ++j) { v0[j] = sigmoidf_(v0[j]); v1[j] = sigmoidf_(v1[j]); } }
                    u32x4 w; w.x = cvt_pk_bf16(v0[0], v0[1]); w.y = cvt_pk_bf16(v0[2], v0[3]); w.z = cvt_pk_bf16(v1[0], v1[1]); w.w = cvt_pk_bf16(v1[2], v1[3]);
                    *(u32x4*)(rowp + bj * HALF) = w; } }
    }
};

template <bool ADD> struct EpiGate {
    static constexpr bool PERM = true, AFTER_DRAIN = false;
    const bf16_t* SG; int sgoff; const bf16_t* M1in; bf16_t* O;
    __device__ __forceinline__ void operator()(const f32x4 (&acc)[2][2][4][2], const Unit& u, int wr, int wc, int fr, int fq) const {
        const int row0 = u.pm * BM + wr * 64 + fr; const int col0 = u.pn * BM + wc * 32 + 8 * fq;
#pragma unroll
        for (int ai = 0; ai < 2; ++ai)
#pragma unroll
            for (int m = 0; m < 4; ++m) { const size_t r = (size_t)(row0 + ai * HALF + m * 16);
#pragma unroll
                for (int bj = 0; bj < 2; ++bj) { const int c = col0 + bj * HALF;
                    const u32x4 s = *(const u32x4*)(SG + r * 2048 + sgoff + c);
                    f32x4 v0 = acc[ai][bj][m][0], v1 = acc[ai][bj][m][1];
                    v0[0] *= bflo(s.x); v0[1] *= bfhi(s.x); v0[2] *= bflo(s.y); v0[3] *= bfhi(s.y); v1[0] *= bflo(s.z); v1[1] *= bfhi(s.z); v1[2] *= bflo(s.w); v1[3] *= bfhi(s.w);
                    if (ADD) { const u32x4 p = *(const u32x4*)(M1in + r * 1024 + c);
                        v0[0] += bflo(p.x); v0[1] += bfhi(p.x); v0[2] += bflo(p.y); v0[3] += bfhi(p.y); v1[0] += bflo(p.z); v1[1] += bfhi(p.z); v1[2] += bflo(p.w); v1[3] += bfhi(p.w); }
                    u32x4 w; w.x = cvt_pk_bf16(v0[0], v0[1]); w.y = cvt_pk_bf16(v0[2], v0[3]); w.z = cvt_pk_bf16(v1[0], v1[1]); w.w = cvt_pk_bf16(v1[2], v1[3]);
                    *(u32x4*)(O + r * 1024 + c) = w; } }
    }
};

struct EpiResid {
    static constexpr bool PERM = false, AFTER_DRAIN = false;
    const float* X; float* OUT;
    __device__ __forceinline__ void operator()(const f32x4 (&acc)[2][2][4][2], const Unit& u, int wr, int wc, int fr, int fq) const {
        typedef unsigned u32x2v __attribute__((ext_vector_type(2)));
        const int row0 = u.pm * BM + wr * 64 + fr; const int col0 = u.pn * BM + wc * 32 + 4 * fq;
#pragma unroll
        for (int ai = 0; ai < 2; ++ai)
#pragma unroll
            for (int m = 0; m < 4; ++m) { const size_t off = (size_t)(row0 + ai * HALF + m * 16) * 1024 + col0;
#pragma unroll
                for (int bj = 0; bj < 2; ++bj)
#pragma unroll
                    for (int n = 0; n < 2; ++n) { const size_t o = off + bj * HALF + n * 16; const f32x4 r = *(const f32x4*)(X + o) + acc[ai][bj][m][n];
                        *(f32x4*)(OUT + o) = r; } }
    }
};

struct EpiSwiglu {
    static constexpr bool PERM = true, AFTER_DRAIN = false;
    const float* RS; const float* WSC; const float* BGU; unsigned char* ACT;
    __device__ __forceinline__ void operator()(const i32x4 (&acc)[2][2][4][2], const Unit& u, int wr, int wc, int fr, int fq) const {
        const int ct = u.pn & 7; const int cw = wc * 32 + 8 * fq;
        const float* bg = BGU + (size_t)u.e * 2048 + ct * 128 + cw; const float* bu = bg + 1024;
        const f32x4 bg0 = *(const f32x4*)bg, bg1 = *(const f32x4*)(bg + 4), bu0 = *(const f32x4*)bu, bu1 = *(const f32x4*)(bu + 4);
        const float* ws = WSC + (size_t)u.pn * 256 + cw;
        const f32x4 wg0 = *(const f32x4*)ws, wg1 = *(const f32x4*)(ws + 4), wu0 = *(const f32x4*)(ws + 128), wu1 = *(const f32x4*)(ws + 132);
#pragma unroll
        for (int ai = 0; ai < 2; ++ai)
#pragma unroll
            for (int m = 0; m < 4; ++m) { const int rr = ai * HALF + wr * 64 + m * 16 + fr; const float rs = RS[u.gl + rr];
                float o[8];
#pragma unroll
                for (int j = 0; j < 4; ++j) {
                    float g = fminf((float)acc[ai][0][m][0][j] * (rs * wg0[j]) + bg0[j], 7.0f), p = fminf(fmaxf((float)acc[ai][1][m][0][j] * (rs * wu0[j]) + bu0[j], -7.0f), 7.0f); o[j] = (p + 1.0f) * (g * sigmoidf_(1.702f * g));
                    g = fminf((float)acc[ai][0][m][1][j] * (rs * wg1[j]) + bg1[j], 7.0f); p = fminf(fmaxf((float)acc[ai][1][m][1][j] * (rs * wu1[j]) + bu1[j], -7.0f), 7.0f); o[4 + j] = (p + 1.0f) * (g * sigmoidf_(1.702f * g)); }
                typedef unsigned u32x2v __attribute__((ext_vector_type(2))); int w0 = 0, w1 = 0;
                w0 = __builtin_amdgcn_cvt_pk_fp8_f32(o[0] * 8.0f, o[1] * 8.0f, w0, false); w0 = __builtin_amdgcn_cvt_pk_fp8_f32(o[2] * 8.0f, o[3] * 8.0f, w0, true);
                w1 = __builtin_amdgcn_cvt_pk_fp8_f32(o[4] * 8.0f, o[5] * 8.0f, w1, false); w1 = __builtin_amdgcn_cvt_pk_fp8_f32(o[6] * 8.0f, o[7] * 8.0f, w1, true);
                *(u32x2v*)(ACT + (size_t)(u.ob + rr) * 1024 + ct * 128 + cw) = (u32x2v){(unsigned)w0, (unsigned)w1}; }
    }
};

struct EpiDown {
    static constexpr bool PERM = true, AFTER_DRAIN = false;
    const float* GW; const float* WSC; const float* BD; bf16_t* Y;
    __device__ __forceinline__ void operator()(const f32x4 (&acc)[2][2][4][2], const Unit& u, int wr, int wc, int fr, int fq) const {
        const int ct = u.pn & 3; const int col0 = ct * 256 + wc * 32 + 8 * fq;
        const float* bd = BD + (size_t)u.e * 1024 + col0; const float* ws = WSC + (size_t)u.e * 1024 + col0;
        f32x4 bv[2][2], wv[2][2];
#pragma unroll
        for (int bj = 0; bj < 2; ++bj)
#pragma unroll
            for (int n = 0; n < 2; ++n) { bv[bj][n] = *(const f32x4*)(bd + bj * HALF + 4 * n); wv[bj][n] = *(const f32x4*)(ws + bj * HALF + 4 * n) * 0.125f; }
#pragma unroll
        for (int ai = 0; ai < 2; ++ai)
#pragma unroll
            for (int m = 0; m < 4; ++m) { const int rr = ai * HALF + wr * 64 + m * 16 + fr; const float gw = GW[u.gl + rr];
#pragma unroll
                for (int bj = 0; bj < 2; ++bj) { const f32x4 v0 = (acc[ai][bj][m][0] * wv[bj][0] + bv[bj][0]) * gw, v1 = (acc[ai][bj][m][1] * wv[bj][1] + bv[bj][1]) * gw;
                    u32x4 w; w.x = cvt_pk_bf16(v0[0], v0[1]); w.y = cvt_pk_bf16(v0[2], v0[3]); w.z = cvt_pk_bf16(v1[0], v1[1]); w.w = cvt_pk_bf16(v1[2], v1[3]);
                    *(u32x4*)(Y + (size_t)(u.ob + rr) * 1024 + col0 + bj * HALF) = w; } }
    }
};

struct MoeOrder {
    int mptj, cntj; int nct, G, c, total, R, TT;
    __device__ __forceinline__ void init(volatile PG8_LAS int* mpt_, volatile PG8_LAS int* mcnt_, int nct_, int G_, int c_, int TT_) {
        const int lane = threadIdx.x & 63;
        mptj = lane < 32 ? mpt_[lane] : 0x7fffffff; cntj = lane < 32 ? mcnt_[lane] : 0;
        nct = nct_; G = G_; c = c_; TT = TT_; R = __builtin_amdgcn_readfirstlane(mpt_[32]); total = R * nct_; }
    __device__ __forceinline__ bool next(int i, Unit& u) const {
        const int L = i * G + c; if (L >= total) return false;
        int wgid = L; { const int q = total / NXCD, r = total % NXCD, xcd = wgid % NXCD, off = wgid / NXCD; wgid = (xcd < r ? xcd * (q + 1) : r * (q + 1) + (xcd - r) * q) + off; }
        const int nig = WGM * nct, gid = wgid / nig, fm = gid * WGM, gsz = (R - fm) < WGM ? (R - fm) : WGM;
        const int rtg = fm + ((wgid % nig) % gsz), ct = (wgid % nig) / gsz;
        const unsigned long long bm = __ballot(mptj <= rtg); const int e = __builtin_popcountll(bm) - 1;
        const int rt = rtg - __builtin_amdgcn_readlane(mptj, e);
        u.pm = rtg; u.pn = e * nct + ct; u.e = e; u.ob = rtg * 256; u.gl = e * TT + rt * 256; u.gn = __builtin_amdgcn_readlane(cntj, e) - rt * 256; return true;
    }
    __device__ __forceinline__ void a_ready(const Unit&) const {}
    __device__ __forceinline__ void done(const Unit&) const {}
};
}
#ifndef PG8_SP2
#define PG8_SP2 true
#endif
#ifndef PG8_ALIGN
#define PG8_ALIGN true
#endif
#ifndef MK_PER_PHASE
#define MK_PER_PHASE 0
#endif
constexpr int NWAVES = 8;
constexpr int BATCH = 16, SEQ = 2048, DM = 1024, T = BATCH * SEQ;
constexpr int NH = 12, AW = 768, INW = 5888, NE = 32;
constexpr float EPS = 1e-6f;
constexpr int N_PHASES = 11;
constexpr size_t MiB = 1u << 20;
constexpr size_t WS_CTL = 0, CTL_ZERO_BYTES = 1 * MiB;
constexpr size_t WS_WIN = 2 * MiB;
constexpr size_t WS_WA = 14 * MiB, WS_WB = 16 * MiB;
constexpr size_t WS_WOUT = 18 * MiB;
constexpr size_t WS_WSP = 20 * MiB;
constexpr size_t WS_WRH = 21 * MiB, WS_WRL = 21 * MiB + 65536;
constexpr size_t WS_WSC = 21 * MiB + 262144;
constexpr size_t WS_WSCIN = 21 * MiB + 524288;
constexpr size_t WS_WSCD = 21 * MiB + 786432;
constexpr size_t WS_XS = 31 * MiB;
constexpr size_t WS_ROPE = 22 * MiB;
constexpr size_t WS_TE = 30 * MiB, WS_TP = 30 * MiB + 524288;
constexpr size_t WS_WGU = 32 * MiB;
constexpr size_t WS_WD = 160 * MiB;
constexpr size_t WS_XN = 224 * MiB;
constexpr size_t WS_QKV = 288 * MiB;
constexpr size_t WS_Z = 432 * MiB;
constexpr size_t WS_GT = 528 * MiB;
constexpr size_t WS_ATT = 656 * MiB, WS_SGU = 704 * MiB;
constexpr size_t WS_LSE = 752 * MiB;
constexpr size_t WS_ACT = 288 * MiB;
constexpr size_t WS_Y = 560 * MiB;
constexpr size_t WS_LIST = 832 * MiB, WS_GWL = 837 * MiB, WS_RS = 842 * MiB;
constexpr size_t WS_END = 848 * MiB;
constexpr int CW_TMO = 0, CW_CODE = 1, CW_BAR = 4096, CW_CNT = 8192;
constexpr int RING_OFF = 0, RING_BYTES = 131072;
constexpr int LDSCTL_OFF = RING_BYTES, MISC_OFF = LDSCTL_OFF + 320;
constexpr int TOKTAB_OFF = LDSCTL_OFF + 1024;
constexpr int MOE_OFF = TOKTAB_OFF + 4096;
constexpr int LDS_BYTES = 147456;
static_assert(MOE_OFF + 1024 + 2048 <= LDS_BYTES, "LDS map");
#define GAS __attribute__((address_space(1)))
#define LAS __attribute__((address_space(3)))
typedef unsigned short bf16;
typedef unsigned v4u __attribute__((ext_vector_type(4)));
typedef float f32x4 __attribute__((ext_vector_type(4)));
typedef short bf16x8 __attribute__((ext_vector_type(8)));
typedef GAS unsigned gu32;
typedef GAS unsigned long long gu64;
#define RLX_AGENT __ATOMIC_RELAXED, __HIP_MEMORY_SCOPE_AGENT
#define LDS_WAIT() asm volatile("s_waitcnt lgkmcnt(0)" ::: "memory")
#define VM_WAIT() asm volatile("s_waitcnt vmcnt(0)" ::: "memory")
__device__ __forceinline__ unsigned long long rt() { return __builtin_amdgcn_s_memrealtime(); }
__device__ __forceinline__ unsigned f2bf(float f) { unsigned u = __builtin_bit_cast(unsigned, f); return (u + 0x7fffu + ((u >> 16) & 1u)) >> 16; }
__device__ __forceinline__ unsigned pk2(float lo, float hi) { return f2bf(lo) | (f2bf(hi) << 16); }

#define XB_TMO      128
#define XB_XCNT(j)  (256  + 64 * (j))
#define XB_XSUB(j)  (1280 + 64 * (j))
#define XB_XGEN(j)  (2304 + 64 * (j))
#define XB_TOP      3328
#define XB_TOPGEN   3392
#define XCD_BAR_WORDS 3456
#define XB_SPIN_CAP (1u << 18)

__device__ __forceinline__ unsigned xb_ld(unsigned* p)              { return __hip_atomic_load(p, __ATOMIC_RELAXED, __HIP_MEMORY_SCOPE_AGENT); }
__device__ __forceinline__ unsigned xb_add(unsigned* p, unsigned v) { return __hip_atomic_fetch_add(p, v, __ATOMIC_RELAXED, __HIP_MEMORY_SCOPE_AGENT); }
__device__ __forceinline__ unsigned xb_xcc_id() { return (unsigned)__builtin_amdgcn_s_getreg((3 << 11) | 20) & 0xFu; }
#define XB_SPIN(cond, bar) do { unsigned _sp = 0; while (cond) { __builtin_amdgcn_s_sleep(1); \
    if ((++_sp & 255u) == 0u) { if (xb_ld(&(bar)[XB_TMO])) break; if (_sp > XB_SPIN_CAP) { atomicAdd(&(bar)[XB_TMO], 1u); break; } } } } while (0)

struct XcdBarrier {
    unsigned* bar; unsigned x;
    volatile LAS unsigned* st;
};

__device__ __forceinline__ XcdBarrier xcd_barrier_post(unsigned* bar, volatile LAS unsigned* st) {
    XcdBarrier b; b.bar = bar; b.x = xb_xcc_id(); b.st = st;
    if (threadIdx.x == 0) (void)xb_add(&bar[XB_XCNT(b.x)], 1u);
    return b;
}
__device__ __forceinline__ void xcd_barrier_complete(unsigned* bar, unsigned x, unsigned& nloc, unsigned& nx) {
    const unsigned G = gridDim.x * gridDim.y * gridDim.z;
    unsigned sum, cnt, mine, sp = 0u;
    for (;;) {
        sum = 0u; cnt = 0u; mine = 0u;
#pragma unroll
        for (unsigned j = 0; j < 16; ++j) { const unsigned c = xb_ld(&bar[XB_XCNT(j)]); sum += c; cnt += (c > 0u) ? 1u : 0u; mine = (j == x) ? c : mine; }
        if (sum == G) break;
        __builtin_amdgcn_s_sleep(1);
        if ((++sp & 255u) == 0u) { if (xb_ld(&bar[XB_TMO])) break; if (sp > XB_SPIN_CAP) { atomicAdd(&bar[XB_TMO], 1u); break; } }
    }
    nloc = mine > 0u ? mine : 1u; nx = cnt > 0u ? cnt : 1u;
}

__device__ __forceinline__ void xcd_barrier(const XcdBarrier& b) {
    asm volatile("s_waitcnt vmcnt(0)" ::: "memory");
    __syncthreads();
    if (threadIdx.x == 0) {
        unsigned* bar = b.bar;
        __builtin_amdgcn_s_waitcnt(0);
        unsigned nloc = b.st[0], nx = b.st[1];
        if (nloc == 0u) { xcd_barrier_complete(bar, b.x, nloc, nx); b.st[0] = nloc; b.st[1] = nx; }
        const unsigned old = xb_add(&bar[XB_XSUB(b.x)], 1u);
        const unsigned gen = old / nloc;
        if (old + 1u == (gen + 1u) * nloc) {
            __builtin_amdgcn_fence(__ATOMIC_RELEASE, "agent");
            asm volatile("s_waitcnt vmcnt(0)" ::: "memory");
            const unsigned og = xb_add(&bar[XB_TOP], 1u);
            const unsigned tg = og / nx;
            if (og + 1u == (tg + 1u) * nx) xb_add(&bar[XB_TOPGEN], 1u);
            else XB_SPIN(xb_ld(&bar[XB_TOPGEN]) == tg, bar);
            __builtin_amdgcn_fence(__ATOMIC_ACQUIRE, "agent");
            xb_add(&bar[XB_XGEN(b.x)], 1u);
            asm volatile("s_waitcnt vmcnt(0)" ::: "memory");
        } else {
            XB_SPIN(xb_ld(&bar[XB_XGEN(b.x)]) == gen, bar);
            __builtin_amdgcn_fence(__ATOMIC_ACQUIRE, "agent");
            asm volatile("s_waitcnt vmcnt(0)" ::: "memory");
        }
    }
    __syncthreads();
}
typedef short v4i16_t __attribute__((ext_vector_type(4)));
typedef unsigned u32x2 __attribute__((ext_vector_type(2)));
struct Frame {
    LAS unsigned char* lds;
    volatile LAS unsigned* MISC;
    gu32* ctl;
    int tid, lane, wave;
    int vcu, G;
    const float* x; const int* positions; const float *norm1_g, *w_in, *q_norm_g, *k_norm_g, *sgu_ln_g, *sgu_ln_b, *w_spatial, *b_spatial, *w_branch_a, *w_branch_b, *w_out, *norm2_g,
        *w_router, *b_router, *w_gate_up, *b_gate_up, *w_down, *b_down;
    float* out;
    bf16 *WIN, *WA, *WB, *WOUT, *WSP, *WRH, *WRL, *WGU, *WD, *XN, *QKV, *Z, *GT, *ATT, *SGU, *ACT, *Y;
    float *ROPE, *LSE, *GWL, *RS, *WSC, *WSCIN, *WSCD, *XS; int *TE, *TP, *LIST; unsigned char* XQ;
};
__device__ __forceinline__ float wave_sum(float v) {
#pragma unroll
    for (int o = 1; o < 64; o <<= 1) v += __shfl_xor(v, o);
    return v;
}
__device__ __forceinline__ float bf_lo(unsigned w) { return __uint_as_float(w << 16); }
__device__ __forceinline__ float bf_hi(unsigned w) { return __uint_as_float(w & 0xffff0000u); }
__device__ __forceinline__ f32x4 mfma16(bf16x8 a, bf16x8 b, f32x4 c) { return __builtin_amdgcn_mfma_f32_16x16x32_bf16(a, b, c, 0, 0, 0); }

struct StripDesc { const float* W; int K, N, n0; void* dst; size_t drow; float* wsc; int mode; bool ksc; };
__device__ __forceinline__ void strip_decode(const Frame& F, int it, StripDesc& d) {
    constexpr int I_IN = 184, I_A = 32, I_GU = 32 * 64, I_D = 32 * 32;
    int r = it; d.ksc = false; d.wsc = nullptr; d.mode = 0;
    if (r < I_GU) { const int e = r >> 6, n0 = 32 * (r & 63); const int nn = n0 & 1023;
        d.W = F.w_gate_up + (size_t)e * 1024 * 2048; d.K = 1024; d.N = 2048; d.n0 = n0; d.dst = F.WGU; d.drow = (size_t)e * 2048 + (nn >> 7) * 256 + (n0 >= 1024 ? 128 : 0) + (nn & 127); d.wsc = F.WSC; d.mode = 1; d.ksc = true; return; } r -= I_GU;
    if (r < I_D) { const int e = r >> 5, n0 = 32 * (r & 31); d.W = F.w_down + (size_t)e * 1024 * 1024; d.K = 1024; d.N = 1024; d.n0 = n0; d.dst = F.WD; d.drow = (size_t)e * 1024 + n0; d.wsc = F.WSCD; d.mode = 2; return; } r -= I_D;
    if (r < I_IN) { d.W = F.w_in; d.K = 1024; d.N = INW; d.n0 = 32 * r; d.dst = F.WIN; d.drow = 32 * r; d.wsc = F.WSCIN; d.mode = 1; return; } r -= I_IN;
    if (r < I_A) { d.W = F.w_branch_a; d.K = 768; d.N = 1024; d.n0 = 32 * r; d.dst = F.WA; d.drow = 32 * r; return; } r -= I_A;
    if (r < I_A) { d.W = F.w_branch_b; d.K = 768; d.N = 1024; d.n0 = 32 * r; d.dst = F.WB; d.drow = 32 * r; return; } r -= I_A;
    d.W = F.w_out; d.K = 1024; d.N = 1024; d.n0 = 32 * r; d.dst = F.WOUT; d.drow = 32 * r;
}
__device__ __forceinline__ void strip_load(const StripDesc& d, int tid, f32x4 (&R)[16]) {
#pragma unroll
    for (int j = 0; j < 16; ++j) { const int idx = tid + j * (NWAVES * 64), k = idx >> 3, c = idx & 7; if (k < d.K) R[j] = *(const GAS f32x4*)(d.W + (size_t)k * d.N + d.n0 + c * 4); }
}
__device__ __forceinline__ void strip_to_lds(const StripDesc& d, int tid, const f32x4 (&R)[16], LAS float* S) {
#pragma unroll
    for (int j = 0; j < 16; ++j) { const int idx = tid + j * (NWAVES * 64), k = idx >> 3, c = idx & 7; if (k < d.K) *(LAS f32x4*)(S + k * 32 + c * 4) = R[j]; }
}
__device__ __forceinline__ void strip_process(const StripDesc& d, int tid, LAS float* S, LAS float* red, LAS float* g2s) {
    const int K = d.K, n = tid & 31, kseg = tid >> 5, nseg = K >> 6; const bool act = kseg < nseg;
    float v[64];
#pragma unroll
    for (int j = 0; j < 64; ++j) v[j] = act ? S[(kseg * 64 + j) * 32 + n] : 0.f;
    if (d.ksc) {
#pragma unroll
        for (int j = 0; j < 64; ++j) v[j] *= g2s[kseg * 64 + j]; }
    if (d.mode != 0) {
        float am = 0.f;
#pragma unroll
        for (int j = 0; j < 64; ++j) am = fmaxf(am, fabsf(v[j]));
        red[kseg * 32 + n] = am;
        __syncthreads();
        float a = 0.f;
        for (int s = 0; s < nseg; ++s) a = fmaxf(a, red[s * 32 + n]);
        const float top = (d.mode == 1) ? 127.0f : 416.0f;
        const float inv = a > 0.f ? top / a : 0.f;
        if (kseg == 0) d.wsc[d.drow + n] = a / top;
        if (act) { GAS v4u* o = (GAS v4u*)((char*)d.dst + (d.drow + n) * (size_t)K + kseg * 64);
#pragma unroll
            for (int q = 0; q < 4; ++q) { unsigned w[4];
#pragma unroll
                for (int u = 0; u < 4; ++u) { const float* vv = v + q * 16 + u * 4; unsigned x = 0u;
                    if (d.mode == 1) {
#pragma unroll
                        for (int b = 0; b < 4; ++b) { const int iv = (int)rintf(vv[b] * inv); x |= ((unsigned)iv & 0xffu) << (8 * b); } }
                    else { int t = 0; t = __builtin_amdgcn_cvt_pk_fp8_f32(vv[0] * inv, vv[1] * inv, t, false); t = __builtin_amdgcn_cvt_pk_fp8_f32(vv[2] * inv, vv[3] * inv, t, true); x = (unsigned)t; }
                    w[u] = x; }
                o[q] = (v4u){w[0], w[1], w[2], w[3]}; } }
    } else {
        if (act) { GAS v4u* o = (GAS v4u*)((bf16*)d.dst + (d.drow + n) * (size_t)K + kseg * 64);
#pragma unroll
            for (int q = 0; q < 8; ++q) o[q] = (v4u){pk2(v[q * 8], v[q * 8 + 1]), pk2(v[q * 8 + 2], v[q * 8 + 3]), pk2(v[q * 8 + 4], v[q * 8 + 5]), pk2(v[q * 8 + 6], v[q * 8 + 7])}; }
    }
}
__device__ __forceinline__ void p0_prologue(Frame& F) {
    const int gw = F.vcu * NWAVES + F.wave, NGW = F.G * NWAVES, lane = F.lane, tid = F.tid;
    constexpr int NITEMS = 184 + 2 * 32 + 32 + 32 * 64 + 32 * 32;
    LAS float* S = (LAS float*)F.lds; LAS float* g2s = (LAS float*)(F.lds + TOKTAB_OFF); LAS float* red = (LAS float*)(F.lds + MOE_OFF + 1024);
    for (int k = tid; k < 1024; k += NWAVES * 64) g2s[k] = F.norm2_g[k];
    {
        StripDesc cur, nxt; f32x4 R[16];
        int it = F.vcu; bool have = it < NITEMS;
        if (have) { strip_decode(F, it, cur); strip_load(cur, tid, R); }
        while (have) {
            strip_to_lds(cur, tid, R, S);
            __syncthreads();
            const int itn = it + F.G; const bool hn = itn < NITEMS;
            if (hn) { strip_decode(F, itn, nxt); strip_load(nxt, tid, R); }
            strip_process(cur, tid, S, red, g2s);
            __syncthreads();
            cur = nxt; it = itn; have = hn;
        }
    }
    for (int m = gw; m < T; m += NGW) {
        const GAS f32x4* xr = (const GAS f32x4*)(F.x + (size_t)m * DM) + lane; const GAS f32x4* gr = (const GAS f32x4*)F.norm1_g + lane;
        f32x4 v[4]; float s = 0.f, am = 0.f;
#pragma unroll
        for (int j = 0; j < 4; ++j) { v[j] = xr[64 * j]; s += (v[j].x * v[j].x + v[j].y * v[j].y) + (v[j].z * v[j].z + v[j].w * v[j].w); v[j] = v[j] * gr[64 * j];
            am = fmaxf(fmaxf(am, fmaxf(fabsf(v[j].x), fabsf(v[j].y))), fmaxf(fabsf(v[j].z), fabsf(v[j].w))); }
        const float rstd = 1.0f / sqrtf(wave_sum(s) * (1.f / DM) + EPS);
#pragma unroll
        for (int o = 1; o < 64; o <<= 1) am = fmaxf(am, __shfl_xor(am, o));
        const float qinv = am > 0.f ? 127.0f / am : 0.f;
        GAS unsigned* o4 = (GAS unsigned*)(F.XQ + (size_t)m * DM) + lane;
#pragma unroll
        for (int j = 0; j < 4; ++j) o4[64 * j] = ((unsigned)(int)rintf(v[j].x * qinv) & 0xffu) | (((unsigned)(int)rintf(v[j].y * qinv) & 0xffu) << 8) | (((unsigned)(int)rintf(v[j].z * qinv) & 0xffu) << 16) | (((unsigned)(int)rintf(v[j].w * qinv) & 0xffu) << 24);
        if (lane == 0) F.XS[m] = rstd * am * (1.0f / 127.0f);
    }
    const int gt = F.vcu * (NWAVES * 64) + F.tid, NGT = F.G * NWAVES * 64;
    for (int i = gt; i < 12 * 128 * 128; i += NGT) { const int s = i & 127, t = (i >> 7) & 127; F.WSP[i] = (bf16)((s <= t) ? f2bf(F.w_spatial[i]) : 0u); }
    for (int i = gt; i < T * 32; i += NGT) { const int t = i >> 5, f = i & 31;
        const float inv = powf(10000.0f, -(float)f * (1.0f / 32.0f)); const float ang = (float)F.positions[t] * inv;
        const double rev = (double)ang * 0.15915494309189535; const float fr = (float)(rev - floor(rev));
        F.ROPE[2 * i] = __builtin_amdgcn_cosf(fr); F.ROPE[2 * i + 1] = __builtin_amdgcn_sinf(fr); }
    for (int i = gt; i < 32 * 1024; i += NGT) { const int e = i >> 10, k = i & 1023; const float v = F.norm2_g[k] * F.w_router[k * 32 + e];
        const unsigned h = f2bf(v); const float hf = __uint_as_float(h << 16); F.WRH[i] = (bf16)h; F.WRL[i] = (bf16)f2bf(v - hf); }
}

__device__ __forceinline__ void p1b_qknorm(Frame& F, bool dry = false) {
    const int gw = F.vcu * NWAVES + F.wave, NGW = F.G * NWAVES, lane = F.lane, c = lane & 7;
    for (int t = gw; t < T; t += NGW) {
        bf16* row = F.QKV + (size_t)t * 2304; const float* tab = F.ROPE + (size_t)t * 64;
#pragma unroll
        for (int it = 0; it < 3; ++it) {
            const int hr = it * 8 + (lane >> 3);
            GAS v4u* p = (GAS v4u*)(row + hr * 64 + c * 8); const v4u raw = *p;
            float v[8] = {bf_lo(raw.x), bf_hi(raw.x), bf_lo(raw.y), bf_hi(raw.y), bf_lo(raw.z), bf_hi(raw.z), bf_lo(raw.w), bf_hi(raw.w)};
            float ss = 0.f;
#pragma unroll
            for (int j = 0; j < 8; ++j) ss += v[j] * v[j];
            ss += __shfl_xor(ss, 1); ss += __shfl_xor(ss, 2); ss += __shfl_xor(ss, 4);
            const float rstd = 1.0f / sqrtf(ss * (1.f / 64.f) + EPS);
            const float* gg = ((hr < 12) ? F.q_norm_g : F.k_norm_g) + c * 8;
            float o[8];
#pragma unroll
            for (int j = 0; j < 8; ++j) v[j] = v[j] * rstd * gg[j];
#pragma unroll
            for (int j = 0; j < 8; ++j) { const float pr = __shfl_xor(v[j], 4); const float cs = tab[2 * ((c & 3) * 8 + j)], sn = tab[2 * ((c & 3) * 8 + j) + 1];
                o[j] = (c < 4) ? (v[j] * cs - pr * sn) : (v[j] * cs + pr * sn); }
            v4u w; w.x = pk2(o[0], o[1]); w.y = pk2(o[2], o[3]); w.z = pk2(o[4], o[5]); w.w = pk2(o[6], o[7]);
            if (dry) *(GAS v4u*)(F.ATT + (size_t)t * 1536 + hr * 64 + c * 8) = w; else *p = w;
        }
    }
}

__device__ __forceinline__ void p2_attention(Frame& F) {
    LAS unsigned char* Ql = F.lds; LAS unsigned char* Kl = F.lds + 16384; LAS unsigned char* Vl = F.lds + 49152;
    const int tid = F.tid, lane = F.lane, w = F.wave, c16 = lane & 15, g = lane >> 4;
    for (int unit = F.vcu; unit < BATCH * NH * 16; unit += F.G) {
        const int b = unit / 192, rem = unit - b * 192, h = rem >> 4, blk = rem & 15;
        const int dsh = 2 * (h >> 2), nbk = 16 >> dsh, r = blk >> (4 - dsh), n = blk & (nbk - 1);
        const bf16* base = F.QKV + (size_t)b * SEQ * 2304 + h * 64;
        v4u qv[2], kv[4], vv[4];
#pragma unroll
        for (int i = 0; i < 2; ++i) { const int idx = tid + i * 512, row = idx >> 3, c = idx & 7; const int s = ((128 * n + row) << dsh) + r; qv[i] = *(const GAS v4u*)(base + (size_t)s * 2304 + c * 8); }
#pragma unroll
        for (int i = 0; i < 4; ++i) { const int idx = tid + i * 512, row = idx >> 3, c = idx & 7; const int mk = 128 * (n - 1) + row;
            if (mk >= 0) { const int s = (mk << dsh) + r; const bf16* p = base + (size_t)s * 2304 + c * 8; kv[i] = *(const GAS v4u*)(p + 768); vv[i] = *(const GAS v4u*)(p + 1536); }
            else { kv[i] = (v4u){0u, 0u, 0u, 0u}; vv[i] = (v4u){0u, 0u, 0u, 0u}; } }
#pragma unroll
        for (int i = 0; i < 2; ++i) { const int idx = tid + i * 512, row = idx >> 3, c = idx & 7; *(LAS v4u*)(Ql + row * 128 + ((c ^ ((row >> 1) & 7)) << 4)) = qv[i]; }
#pragma unroll
        for (int i = 0; i < 4; ++i) { const int idx = tid + i * 512, row = idx >> 3, c = idx & 7;
            *(LAS v4u*)(Kl + row * 128 + ((c ^ ((row >> 1) & 7)) << 4)) = kv[i];
            *(LAS v4u*)(Vl + row * 128 + ((((c >> 1) ^ ((row >> 1) & 3))) << 5) + ((c & 1) << 4)) = vv[i]; }
        __syncthreads();
        {
            const int qrow = 16 * w + c16;
            bf16x8 Qb[2];
#pragma unroll
            for (int ks = 0; ks < 2; ++ks) { const int ch = g + 4 * ks; Qb[ks] = *(const LAS bf16x8*)(Ql + qrow * 128 + ((ch ^ ((qrow >> 1) & 7)) << 4)); }
            f32x4 S[10];
#pragma unroll
            for (int tt = 0; tt < 9; ++tt) { const int krow = 16 * (w + tt) + c16; f32x4 a = (f32x4){0.f, 0.f, 0.f, 0.f};
#pragma unroll
                for (int ks = 0; ks < 2; ++ks) { const int ch = g + 4 * ks; const bf16x8 Ka = *(const LAS bf16x8*)(Kl + krow * 128 + ((ch ^ ((krow >> 1) & 7)) << 4)); a = mfma16(Ka, Qb[ks], a); }
                S[tt] = a; }
            S[9] = (f32x4){0.f, 0.f, 0.f, 0.f};
            float mx = -3.0e38f;
#pragma unroll
            for (int tt = 0; tt < 9; ++tt)
#pragma unroll
                for (int rg = 0; rg < 4; ++rg) { const int j = 16 * (w + tt) + 4 * g + rg, dist = 128 + qrow - j, mk = 128 * (n - 1) + j;
                    const bool valid = (dist >= 0) && (dist <= 128) && (mk >= 0); const float s = valid ? S[tt][rg] * 0.125f : -1.0e30f; S[tt][rg] = s; mx = fmaxf(mx, s); }
            mx = fmaxf(mx, __shfl_xor(mx, 16)); mx = fmaxf(mx, __shfl_xor(mx, 32));
            float sum = 0.f;
#pragma unroll
            for (int tt = 0; tt < 9; ++tt)
#pragma unroll
                for (int rg = 0; rg < 4; ++rg) { const float p = __builtin_amdgcn_exp2f((S[tt][rg] - mx) * 1.4426950408889634f); S[tt][rg] = p; sum += p; }
            sum += __shfl_xor(sum, 16); sum += __shfl_xor(sum, 32);
            f32x4 O[4];
#pragma unroll
            for (int dt = 0; dt < 4; ++dt) O[dt] = (f32x4){0.f, 0.f, 0.f, 0.f};
            const int q4 = (lane >> 2) & 3, p4 = lane & 3;
#pragma unroll
            for (int kp = 0; kp < 5; ++kp) { const int t0 = w + 2 * kp; int t1 = w + 2 * kp + 1; t1 = t1 > 15 ? 15 : t1;
                v4u pw; pw.x = pk2(S[2 * kp][0], S[2 * kp][1]); pw.y = pk2(S[2 * kp][2], S[2 * kp][3]); pw.z = pk2(S[2 * kp + 1][0], S[2 * kp + 1][1]); pw.w = pk2(S[2 * kp + 1][2], S[2 * kp + 1][3]);
                const bf16x8 Pb = __builtin_bit_cast(bf16x8, pw);
                const int r0 = 16 * t0 + 4 * g + q4, r1 = 16 * t1 + 4 * g + q4;
#pragma unroll
                for (int dt = 0; dt < 4; ++dt) {
                    const v4i16_t lo = __builtin_amdgcn_ds_read_tr16_b64_v4i16((LAS v4i16_t*)(Vl + r0 * 128 + ((dt ^ ((r0 >> 1) & 3)) << 5) + p4 * 8));
                    const v4i16_t hi = __builtin_amdgcn_ds_read_tr16_b64_v4i16((LAS v4i16_t*)(Vl + r1 * 128 + ((dt ^ ((r1 >> 1) & 3)) << 5) + p4 * 8));
                    const bf16x8 Va = (bf16x8){lo[0], lo[1], lo[2], lo[3], hi[0], hi[1], hi[2], hi[3]};
                    O[dt] = mfma16(Va, Pb, O[dt]); } }
            const float inv = 1.0f / sum; const int stok = ((128 * n + qrow) << dsh) + r; const size_t grow = (size_t)b * SEQ + stok;
            bf16* op = F.ATT + grow * AW + h * 64 + 4 * g;
#pragma unroll
            for (int dt = 0; dt < 4; ++dt) { u32x2 o2; o2.x = pk2(O[dt][0] * inv, O[dt][1] * inv); o2.y = pk2(O[dt][2] * inv, O[dt][3] * inv); *(GAS u32x2*)(op + 16 * dt) = o2; }
            if (g == 0) F.LSE[grow * 12 + h] = mx + logf(sum);
        }
        __syncthreads();
    }
}

__device__ __forceinline__ void p3_alpha(Frame& F, bool dry = false) {
    const int gw = F.vcu * NWAVES + F.wave, NGW = F.G * NWAVES, lane = F.lane;
    for (int t = gw; t < T; t += NGW) {
        const float* ls = F.LSE + (size_t)t * 12;
        for (int idx = lane; idx < 96; idx += 64) { const int head = idx >> 3, hg = head & 3, gi = head >> 2;
            const float la = ls[hg], lb = ls[4 + hg], lc = ls[8 + hg]; const float m = fmaxf(la, fmaxf(lb, lc));
            const float ea = __expf(la - m), eb = __expf(lb - m), ec = __expf(lc - m); const float al = ((gi == 0) ? ea : (gi == 1) ? eb : ec) / (ea + eb + ec);
            GAS v4u* p = (GAS v4u*)(F.ATT + (size_t)t * AW + idx * 8); const v4u raw = *p; v4u o;
            o.x = pk2(bf_lo(raw.x) * al, bf_hi(raw.x) * al); o.y = pk2(bf_lo(raw.y) * al, bf_hi(raw.y) * al); o.z = pk2(bf_lo(raw.z) * al, bf_hi(raw.z) * al); o.w = pk2(bf_lo(raw.w) * al, bf_hi(raw.w) * al);
            if (dry) *(GAS v4u*)(F.SGU + (size_t)t * AW + idx * 8) = o; else *p = o; }
    }
}
__device__ __forceinline__ void p3_sgu(Frame& F) {
    LAS float* st = (LAS float*)F.lds; LAS unsigned char* vt0 = F.lds + 1024;
    const int tid = F.tid, lane = F.lane, w = F.wave, c16 = lane & 15, g4 = lane >> 4;
    for (int chunk = F.vcu; chunk < T / 128; chunk += F.G) {
        const int t0 = chunk * 128;
        for (int tt = 0; tt < 16; ++tt) { const int tok = t0 + 16 * w + tt; const bf16* vr = F.Z + (size_t)tok * 1536 + 768;
            float v[12]; float s = 0.f;
#pragma unroll
            for (int it = 0; it < 3; ++it) { const u32x2 raw = *(const GAS u32x2*)(vr + it * 256 + lane * 4); v[4 * it] = bf_lo(raw.x); v[4 * it + 1] = bf_hi(raw.x); v[4 * it + 2] = bf_lo(raw.y); v[4 * it + 3] = bf_hi(raw.y); }
#pragma unroll
            for (int j = 0; j < 12; ++j) s += v[j];
            const float mean = wave_sum(s) * (1.f / 768.f); float q = 0.f;
#pragma unroll
            for (int j = 0; j < 12; ++j) { const float d = v[j] - mean; q += d * d; }
            const float rstd = 1.0f / sqrtf(wave_sum(q) * (1.f / 768.f) + EPS);
            if (lane == 0) { st[(16 * w + tt) * 2] = mean; st[(16 * w + tt) * 2 + 1] = rstd; } }
        __syncthreads();
        for (int gg = 0; gg < 12; ++gg) {
            LAS unsigned char* buf = vt0 + (gg & 1) * 17408;
            { const int s = tid >> 2, q = tid & 3; const bf16* src = F.Z + (size_t)(t0 + s) * 1536 + 768 + gg * 64 + q * 16;
                const v4u r0 = *(const GAS v4u*)src, r1 = *(const GAS v4u*)(src + 8);
                const float mean = st[2 * s], rstd = st[2 * s + 1]; const float* lg = F.sgu_ln_g + gg * 64 + q * 16; const float* lb = F.sgu_ln_b + gg * 64 + q * 16;
                const float v[16] = {bf_lo(r0.x), bf_hi(r0.x), bf_lo(r0.y), bf_hi(r0.y), bf_lo(r0.z), bf_hi(r0.z), bf_lo(r0.w), bf_hi(r0.w), bf_lo(r1.x), bf_hi(r1.x), bf_lo(r1.y), bf_hi(r1.y), bf_lo(r1.z), bf_hi(r1.z), bf_lo(r1.w), bf_hi(r1.w)};
#pragma unroll
                for (int jj = 0; jj < 16; ++jj) { const float val = (v[jj] - mean) * rstd * lg[jj] + lb[jj]; *(LAS unsigned short*)(buf + (q * 16 + jj) * 272 + s * 2) = (unsigned short)f2bf(val); } }
            __syncthreads();
            f32x4 acc[4];
#pragma unroll
            for (int mt = 0; mt < 4; ++mt) acc[mt] = (f32x4){0.f, 0.f, 0.f, 0.f};
            for (int ks = 0; ks <= (w >> 1); ++ks) {
                const bf16x8 Bw = *(const GAS bf16x8*)(F.WSP + (size_t)(gg * 128 + 16 * w + c16) * 128 + 32 * ks + 8 * g4);
#pragma unroll
                for (int mt = 0; mt < 4; ++mt) { const bf16x8 Av = *(const LAS bf16x8*)(buf + (16 * mt + c16) * 272 + (32 * ks + 8 * g4) * 2); acc[mt] = mfma16(Av, Bw, acc[mt]); } }
            const int tok = t0 + 16 * w + c16; const float bias = F.b_spatial[gg * 128 + 16 * w + c16];
            const bf16* up = F.Z + (size_t)tok * 1536 + gg * 64 + 4 * g4; bf16* op = F.SGU + (size_t)tok * AW + gg * 64 + 4 * g4;
#pragma unroll
            for (int mt = 0; mt < 4; ++mt) { const u32x2 u = *(const GAS u32x2*)(up + 16 * mt); u32x2 o2;
                o2.x = pk2(bf_lo(u.x) * (acc[mt][0] + bias), bf_hi(u.x) * (acc[mt][1] + bias)); o2.y = pk2(bf_lo(u.y) * (acc[mt][2] + bias), bf_hi(u.y) * (acc[mt][3] + bias));
                *(GAS u32x2*)(op + 16 * mt) = o2; }
        }
        __syncthreads();
    }
}

__device__ __forceinline__ void p6_router(Frame& F) {
    volatile LAS int* hist = (volatile LAS int*)(F.lds + MOE_OFF + 512); volatile LAS int* wbase = hist + 32;
    const int tid = F.tid, lane = F.lane, w = F.wave, c16 = lane & 15, g = lane >> 4;
    for (int chunk = F.vcu; chunk < T / 128; chunk += F.G) {
        if (tid < 32) hist[tid] = 0;
        __syncthreads();
        const int tok = chunk * 128 + w * 16 + c16; const float* xr = F.out + (size_t)tok * DM;
        f32x4 acc[2]; acc[0] = (f32x4){0.f, 0.f, 0.f, 0.f}; acc[1] = (f32x4){0.f, 0.f, 0.f, 0.f}; float ss = 0.f, am = 0.f;
#pragma unroll 4
        for (int ks = 0; ks < 32; ++ks) { const int k0 = 32 * ks + 8 * g;
            const f32x4 a = *(const GAS f32x4*)(xr + k0), b = *(const GAS f32x4*)(xr + k0 + 4);
            const float xv[8] = {a.x, a.y, a.z, a.w, b.x, b.y, b.z, b.w}; unsigned hh[8], ll[8];
#pragma unroll
            for (int j = 0; j < 8; ++j) { ss += xv[j] * xv[j]; am = fmaxf(am, fabsf(xv[j])); hh[j] = f2bf(xv[j]); ll[j] = f2bf(xv[j] - __uint_as_float(hh[j] << 16)); }
            v4u ph, pl; ph.x = hh[0] | (hh[1] << 16); ph.y = hh[2] | (hh[3] << 16); ph.z = hh[4] | (hh[5] << 16); ph.w = hh[6] | (hh[7] << 16);
            pl.x = ll[0] | (ll[1] << 16); pl.y = ll[2] | (ll[3] << 16); pl.z = ll[4] | (ll[5] << 16); pl.w = ll[6] | (ll[7] << 16);
            const bf16x8 xh = __builtin_bit_cast(bf16x8, ph), xl = __builtin_bit_cast(bf16x8, pl);
#pragma unroll
            for (int mt = 0; mt < 2; ++mt) { const bf16x8 wh = *(const GAS bf16x8*)(F.WRH + (size_t)(16 * mt + c16) * 1024 + k0), wl = *(const GAS bf16x8*)(F.WRL + (size_t)(16 * mt + c16) * 1024 + k0);
                acc[mt] = mfma16(wh, xh, acc[mt]); acc[mt] = mfma16(wh, xl, acc[mt]); acc[mt] = mfma16(wl, xh, acc[mt]); } }
        ss += __shfl_xor(ss, 16); ss += __shfl_xor(ss, 32);
        const float rstd = 1.0f / sqrtf(ss * (1.f / DM) + EPS);
        am = fmaxf(am, __shfl_xor(am, 16)); am = fmaxf(am, __shfl_xor(am, 32));
        { const float qinv = am > 0.f ? 127.0f / am : 0.f; unsigned char* xq = F.XQ + (size_t)tok * DM;
#pragma unroll 4
            for (int ks = 0; ks < 32; ++ks) { const int k0 = 32 * ks + 8 * g;
                const f32x4 a = *(const GAS f32x4*)(xr + k0), b = *(const GAS f32x4*)(xr + k0 + 4);
                const float xv[8] = {a.x, a.y, a.z, a.w, b.x, b.y, b.z, b.w}; unsigned wlo = 0u, whi = 0u;
#pragma unroll
                for (int j = 0; j < 4; ++j) { wlo |= ((unsigned)(int)rintf(xv[j] * qinv) & 0xffu) << (8 * j); whi |= ((unsigned)(int)rintf(xv[4 + j] * qinv) & 0xffu) << (8 * j); }
                *(GAS u32x2*)(xq + k0) = (u32x2){wlo, whi}; } }
        const float rsq = rstd * am * (1.0f / 127.0f);
        float lg[8];
#pragma unroll
        for (int mt = 0; mt < 2; ++mt)
#pragma unroll
            for (int rg = 0; rg < 4; ++rg) lg[mt * 4 + rg] = acc[mt][rg] * rstd + F.b_router[16 * mt + 4 * g + rg];
        float tv[4]; int te[4];
#pragma unroll
        for (int k = 0; k < 4; ++k) {
            float bv = -3.0e38f; int bi = 0;
#pragma unroll
            for (int s = 0; s < 8; ++s) { const int e = 16 * (s >> 2) + 4 * g + (s & 3); if (lg[s] > bv) { bv = lg[s]; bi = e; } }
#pragma unroll
            for (int o = 16; o < 64; o <<= 1) { const float ov = __shfl_xor(bv, o); const int oi = __shfl_xor(bi, o); if (ov > bv || (ov == bv && oi < bi)) { bv = ov; bi = oi; } }
            tv[k] = bv; te[k] = bi;
#pragma unroll
            for (int s = 0; s < 8; ++s) { const int e = 16 * (s >> 2) + 4 * g + (s & 3); if (e == bi) lg[s] = -3.0e38f; }
        }
        const float e1 = __expf(tv[1] - tv[0]), e2 = __expf(tv[2] - tv[0]), e3 = __expf(tv[3] - tv[0]); const float den = 1.0f / (1.0f + e1 + e2 + e3);
        const float gk = ((g == 0) ? 1.0f : (g == 1) ? e1 : (g == 2) ? e2 : e3) * den; const int ek = (g == 0) ? te[0] : (g == 1) ? te[1] : (g == 2) ? te[2] : te[3];
        const int lpos = atomicAdd((int*)&hist[ek], 1);
        __syncthreads();
        if (tid < 32) { const int cnt = hist[tid]; wbase[tid] = cnt ? (int)__hip_atomic_fetch_add(F.ctl + CW_CNT + 64 * tid, (unsigned)cnt, RLX_AGENT) : 0; }
        __syncthreads();
        const int pos = wbase[ek] + lpos; const size_t li = (size_t)ek * T + pos;
        F.LIST[li] = tok; F.GWL[li] = gk; F.RS[li] = rsq; F.TE[tok * 4 + g] = ek; F.TP[tok * 4 + g] = pos;
        __syncthreads();
    }
}
__device__ __forceinline__ void moe_tables(Frame& F) {
    volatile LAS int* mpt = (volatile LAS int*)(F.lds + MOE_OFF); volatile LAS int* mcnt = mpt + 64;
    if (F.tid == 0) { int a = 0; for (int e = 0; e < 32; ++e) { const int c = (int)__hip_atomic_load(F.ctl + CW_CNT + 64 * e, RLX_AGENT); mcnt[e] = c; mpt[e] = a; a += (c + 255) >> 8; } mpt[32] = a; }
    __syncthreads();
}
__device__ __forceinline__ void p9_combine(Frame& F, bool dry = false) {
    volatile LAS int* mpt = (volatile LAS int*)(F.lds + MOE_OFF);
    const int gw = F.vcu * NWAVES + F.wave, NGW = F.G * NWAVES, lane = F.lane;
    for (int t = gw; t < T; t += NGW) {
        size_t srow[4];
#pragma unroll
        for (int k = 0; k < 4; ++k) { const int e = F.TE[t * 4 + k], p = F.TP[t * 4 + k]; srow[k] = ((size_t)mpt[e] * 256 + p) * 1024; }
        GAS f32x4* o = (GAS f32x4*)(F.out + (size_t)t * DM) + lane;
#pragma unroll
        for (int it = 0; it < 4; ++it) { f32x4 v = o[64 * it];
#pragma unroll
            for (int k = 0; k < 4; ++k) { const u32x2 y = *(const GAS u32x2*)(F.Y + srow[k] + it * 256 + lane * 4); v.x += bf_lo(y.x); v.y += bf_hi(y.x); v.z += bf_lo(y.y); v.w += bf_hi(y.y); }
            if (dry) ((GAS f32x4*)((float*)F.WGU + (size_t)t * DM) + lane)[64 * it] = v; else o[64 * it] = v; }
    }
}

struct Args { const void* in[20]; float* out; unsigned char* ws; int ph_lo, ph_hi; };
__global__ void __launch_bounds__(NWAVES * 64, 2) hybrid_fwd(Args args) {
    extern __shared__ __attribute__((aligned(16))) unsigned char lds[];
    Frame F;
    F.lds = (LAS unsigned char*)lds;
    F.MISC = (volatile LAS unsigned*)(F.lds + MISC_OFF);
    F.tid = threadIdx.x; F.lane = F.tid & 63; F.wave = __builtin_amdgcn_readfirstlane(F.tid >> 6);
    F.G = gridDim.x; { const int bx = blockIdx.x; F.vcu = (F.G % 8 == 0) ? (bx % 8) * (F.G / 8) + bx / 8 : bx; }
    unsigned char* ws = args.ws;
    F.ctl = (gu32*)(ws + WS_CTL);
    F.x = (const float*)args.in[0]; F.positions = (const int*)args.in[1]; F.norm1_g = (const float*)args.in[2]; F.w_in = (const float*)args.in[3];
    F.q_norm_g = (const float*)args.in[4]; F.k_norm_g = (const float*)args.in[5]; F.sgu_ln_g = (const float*)args.in[6]; F.sgu_ln_b = (const float*)args.in[7];
    F.w_spatial = (const float*)args.in[8]; F.b_spatial = (const float*)args.in[9]; F.w_branch_a = (const float*)args.in[10]; F.w_branch_b = (const float*)args.in[11];
    F.w_out = (const float*)args.in[12]; F.norm2_g = (const float*)args.in[13]; F.w_router = (const float*)args.in[14]; F.b_router = (const float*)args.in[15];
    F.w_gate_up = (const float*)args.in[16]; F.b_gate_up = (const float*)args.in[17]; F.w_down = (const float*)args.in[18]; F.b_down = (const float*)args.in[19];
    F.out = args.out;
    F.WIN = (bf16*)(ws + WS_WIN); F.WA = (bf16*)(ws + WS_WA); F.WB = (bf16*)(ws + WS_WB); F.WOUT = (bf16*)(ws + WS_WOUT); F.WSP = (bf16*)(ws + WS_WSP);
    F.WRH = (bf16*)(ws + WS_WRH); F.WRL = (bf16*)(ws + WS_WRL); F.WGU = (bf16*)(ws + WS_WGU); F.WD = (bf16*)(ws + WS_WD); F.XN = (bf16*)(ws + WS_XN);
    F.QKV = (bf16*)(ws + WS_QKV); F.Z = (bf16*)(ws + WS_Z); F.GT = (bf16*)(ws + WS_GT); F.ATT = (bf16*)(ws + WS_ATT); F.SGU = (bf16*)(ws + WS_SGU);
    F.ACT = (bf16*)(ws + WS_ACT); F.Y = (bf16*)(ws + WS_Y);
    F.ROPE = (float*)(ws + WS_ROPE); F.LSE = (float*)(ws + WS_LSE); F.GWL = (float*)(ws + WS_GWL); F.RS = (float*)(ws + WS_RS);
    F.WSC = (float*)(ws + WS_WSC); F.WSCIN = (float*)(ws + WS_WSCIN); F.WSCD = (float*)(ws + WS_WSCD); F.XS = (float*)(ws + WS_XS); F.XQ = ws + WS_XN;
    F.TE = (int*)(ws + WS_TE); F.TP = (int*)(ws + WS_TP); F.LIST = (int*)(ws + WS_LIST);
    for (int u = F.tid; u < (LDS_BYTES - LDSCTL_OFF) / 4; u += NWAVES * 64) ((LAS unsigned*)(F.lds + LDSCTL_OFF))[u] = 0u;
    __syncthreads();
    XcdBarrier bar; bar.bar = (unsigned*)(F.ctl + CW_BAR); bar.x = 0; bar.st = nullptr;
    if (!MK_PER_PHASE) bar = xcd_barrier_post((unsigned*)(F.ctl + CW_BAR), F.MISC + 8);
    const int lo = args.ph_lo, hi = args.ph_hi;
#define IN(k) (lo <= (k) && (k) < hi)
#ifndef PROBE_WHICH
#define PROBE_WHICH -1
#endif
#ifndef PROBE_REP
#define PROBE_REP 0
#endif
#define REP(k) for (int rep_ = ((PROBE_REP >> (k)) & 1); rep_ >= 0; --rep_)
#define DRY (rep_ > 0)
#ifndef PROBE_PHASE
#define PROBE_PHASE -1
#endif
    unsigned long long pph_ = 0ull; (void)pph_;
#define PSTART(k) do { if ((k) == PROBE_PHASE) pph_ = rt(); } while (0)
#define SEAM(k) do { if (!MK_PER_PHASE && IN(k) && IN((k) + 1)) xcd_barrier(bar); if ((k) == PROBE_PHASE && F.tid == 0) *(LAS unsigned*)(F.lds + 131072 + 256) += (unsigned)(rt() - pph_); } while (0)
    bf16* const M1 = F.XN; bf16* const MERGED = F.Z;
    PG8_LAS unsigned* toktab = (PG8_LAS unsigned*)(F.lds + TOKTAB_OFF);
    volatile PG8_LAS int* mpt = (volatile PG8_LAS int*)(F.lds + MOE_OFF); volatile PG8_LAS int* mcnt = mpt + 64;

    if (IN(0)) { PSTART(0); REP(0) p0_prologue(F); SEAM(0); }
    if (IN(1)) { PSTART(1); REP(1) {
        pg8::Gemm g{(const bf16*)F.XQ, F.WIN, T, INW, DM / 2}; pg8::StaticOrder S; S.init(T, INW, F.G, (int)blockIdx.x);
        pg8::EpiProj E{F.XS, F.WSCIN, F.QKV, F.Z, F.GT};
        pg8::gemm_phase<pg8::EpiProj, pg8::StaticOrder, PG8_ALIGN, true, false, 1>(F.lds + RING_OFF, g, S, E, nullptr, nullptr, PROBE_WHICH == 1); }
        SEAM(1);
    }
    if (IN(2)) { PSTART(2); REP(2) p1b_qknorm(F, DRY); SEAM(2); }
    if (IN(3)) { PSTART(3); REP(3) p2_attention(F); SEAM(3); }
    if (IN(4)) { PSTART(4); REP(4) p3_alpha(F, DRY); REP(11) p3_sgu(F); SEAM(4); }
    if (IN(5)) { PSTART(5); REP(5) {
        pg8::StaticOrder S; S.init(T, DM, F.G, (int)blockIdx.x);
        { pg8::Gemm g{F.ATT, F.WA, T, DM, AW}; pg8::EpiGate<false> E{F.GT, 0, nullptr, M1};
          pg8::gemm_phase<pg8::EpiGate<false>, pg8::StaticOrder, PG8_ALIGN, PG8_SP2>(F.lds + RING_OFF, g, S, E); }
        VM_WAIT(); __builtin_amdgcn_fence(__ATOMIC_SEQ_CST, "agent"); VM_WAIT(); __syncthreads();
        { pg8::Gemm g{F.SGU, F.WB, T, DM, AW}; pg8::EpiGate<true> E{F.GT, 1024, M1, MERGED};
          pg8::gemm_phase<pg8::EpiGate<true>, pg8::StaticOrder, PG8_ALIGN, PG8_SP2>(F.lds + RING_OFF, g, S, E); } }
        SEAM(5);
    }
    if (IN(6)) { PSTART(6); REP(6) {
        pg8::Gemm g{MERGED, F.WOUT, T, DM, DM}; pg8::StaticOrder S; S.init(T, DM, F.G, (int)blockIdx.x);
        pg8::EpiResid E{F.x, F.out};
        pg8::gemm_phase<pg8::EpiResid, pg8::StaticOrder, PG8_ALIGN, PG8_SP2>(F.lds + RING_OFF, g, S, E); }
        SEAM(6);
    }
    if (IN(7)) { PSTART(7); p6_router(F); SEAM(7); }
    if (IN(8)) { PSTART(8);
        moe_tables(F); REP(8) {
        pg8::Gemm g{(const bf16*)F.XQ, F.WGU, 0, 0, DM / 2}; pg8::MoeOrder S; S.init(mpt, mcnt, 8, F.G, (int)blockIdx.x, T);
        pg8::EpiSwiglu E{F.RS, F.WSC, F.b_gate_up, (unsigned char*)F.ACT};
        pg8::gemm_phase<pg8::EpiSwiglu, pg8::MoeOrder, PG8_ALIGN, true, true, 1>(F.lds + RING_OFF, g, S, E, toktab, F.LIST, PROBE_WHICH == 8); }
        SEAM(8);
    }
    if (IN(9)) { PSTART(9);
        moe_tables(F); REP(9) {
        pg8::Gemm g{F.ACT, F.WD, 0, 0, DM / 2}; pg8::MoeOrder S; S.init(mpt, mcnt, 4, F.G, (int)blockIdx.x, T);
        pg8::EpiDown E{F.GWL, F.WSCD, F.b_down, F.Y};
        pg8::gemm_phase<pg8::EpiDown, pg8::MoeOrder, PG8_ALIGN, true, false, 2>(F.lds + RING_OFF, g, S, E, nullptr, nullptr, PROBE_WHICH == 9); }
        SEAM(9);
    }
    if (IN(10)) { moe_tables(F); REP(10) p9_combine(F, DRY); }
#ifdef PG8_PROBE
    if (blockIdx.x == 0 && F.tid == 0) { const unsigned ticks = *(LAS unsigned*)(F.lds + 131072 + 256); const unsigned long long t0 = rt(); while (rt() - t0 < (unsigned long long)ticks) __builtin_amdgcn_s_sleep(8); }
#endif
#undef IN
#undef SEAM
}

extern "C" void kernel_launch(void* const* d_in, const int* in_sizes, int n_in, void* d_out, int out_size, void* d_ws, size_t ws_size, hipStream_t stream) {
    static int grid = 0;
    if (grid == 0) {
        if (n_in != 20 || out_size != T * DM || ws_size < WS_END) { fprintf(stderr, "kernel_launch: unexpected shapes (n_in %d, out %d, ws %zu)\n", n_in, out_size, ws_size); grid = -1; return; }
        int dev = 0, cus = 0;
        if (hipGetDevice(&dev) != hipSuccess || hipDeviceGetAttribute(&cus, hipDeviceAttributeMultiprocessorCount, dev) != hipSuccess) { grid = -1; return; }
        if (hipFuncSetAttribute((const void*)hybrid_fwd, hipFuncAttributeMaxDynamicSharedMemorySize, LDS_BYTES) != hipSuccess) { fprintf(stderr, "kernel_launch: hipFuncSetAttribute failed\n"); grid = -1; return; }
        int per_cu = 0;
        if (hipOccupancyMaxActiveBlocksPerMultiprocessor(&per_cu, (const void*)hybrid_fwd, NWAVES * 64, LDS_BYTES) != hipSuccess || per_cu < 1) fprintf(stderr, "kernel_launch: occupancy query reports %d\n", per_cu);
        (void)hipGetLastError();
        grid = cus;
    }
    if (grid < 0) return;
    if (hipMemsetAsync((char*)d_ws + WS_CTL, 0, CTL_ZERO_BYTES, stream) != hipSuccess) return;
    Args a{};
    for (int i = 0; i < 20; ++i) a.in[i] = d_in[i];
    a.out = (float*)d_out; a.ws = (unsigned char*)d_ws;
#if MK_PER_PHASE
    for (int p = 0; p < N_PHASES; ++p) { a.ph_lo = p; a.ph_hi = p + 1; hipLaunchKernelGGL(hybrid_fwd, dim3(grid), dim3(NWAVES * 64), LDS_BYTES, stream, a); }
#else
    a.ph_lo = 0; a.ph_hi = N_PHASES;
    hipLaunchKernelGGL(hybrid_fwd, dim3(grid), dim3(NWAVES * 64), LDS_BYTES, stream, a);
#endif
}
```
